# Optimizing an MI355X kernel written in HIP

```python
import jax, jax.numpy as jnp
from jax import lax
import numpy as np

D_MODEL = 2048
BATCH = 1
SEQ = 8192
DEPTH = 2

CHUNK = 64
Q_BLOCK = 128
HEAD_DIM = 128
N_HEADS_A = 8
N_HEADS_B = 8
ROT_DIM = HEAD_DIM // 4
ROPE_THETA = 500000.0
N_IDX_HEADS = 16
IDX_DIM = 64
IDX_ROT_DIM = IDX_DIM // 4
TOPK_MAX = 256
POOL_GROUPS = 4
POOL_WINDOWS = (2, 4, 8, 16)
POOL_WIDTH = D_MODEL // POOL_GROUPS
D_FF = 5632
N_EXPERTS = 8
TOP_K_EXPERTS = 2
D_FF_EXPERT = 7168
N_EVEN = (DEPTH + 1) // 2
N_ODD = DEPTH // 2
RMS_EPS = 1e-6

IN_SPLITS = (
    N_HEADS_A * HEAD_DIM,
    N_HEADS_A * HEAD_DIM,
    N_HEADS_A * HEAD_DIM,
    N_IDX_HEADS * IDX_DIM,
    IDX_DIM,
    N_IDX_HEADS,
    N_HEADS_B * HEAD_DIM,
    N_HEADS_B * HEAD_DIM,
    N_HEADS_B * HEAD_DIM,
    N_HEADS_B,
    N_HEADS_B * HEAD_DIM,
)
IN_DIM = sum(IN_SPLITS)

kernel_name = "hybrid_dsa_fox_pool_moe_encoder"


def rms_norm(x, g):
    xf = x.astype(jnp.float32)
    y = xf * lax.rsqrt(jnp.mean(xf * xf, axis=-1, keepdims=True) + RMS_EPS)
    return (y * g.astype(jnp.float32)).astype(x.dtype)


def partial_rotary(x, rot_dim):
    S = x.shape[1]
    half = rot_dim // 2
    inv_freq = 1.0 / (ROPE_THETA ** (jnp.arange(half, dtype=jnp.float32) * 2.0 / rot_dim))
    ang = jnp.arange(S, dtype=jnp.float32)[:, None] * inv_freq[None, :]
    cos = jnp.cos(ang)[None, :, None, :]
    sin = jnp.sin(ang)[None, :, None, :]
    xf = x.astype(jnp.float32)
    x1, x2 = xf[..., :half], xf[..., half:rot_dim]
    out = jnp.concatenate([x1 * cos - x2 * sin, x2 * cos + x1 * sin, xf[..., rot_dim:]], axis=-1)
    return out.astype(x.dtype)


def to_blocks(a):
    nb = a.shape[1] // Q_BLOCK
    return jnp.moveaxis(a.reshape((a.shape[0], nb, Q_BLOCK) + a.shape[2:]), 1, 0)


def from_blocks(a):
    a = jnp.moveaxis(a, 0, 1)
    return a.reshape((a.shape[0], a.shape[1] * a.shape[2]) + a.shape[3:])


def dsa_sparse_attention(q, k, v, q_idx, k_idx, w_idx):
    B, S = q.shape[0], q.shape[1]
    top_k = min(TOPK_MAX, S // 4)
    key_chunk = jnp.arange(S) // CHUNK
    scale = HEAD_DIM ** -0.5
    b_ix = jnp.arange(B)[:, None, None]

    def block(args):
        qb, qib, wib, blk = args
        q_chunk = (blk * Q_BLOCK + jnp.arange(Q_BLOCK)) // CHUNK
        adm = key_chunk[None, :] <= q_chunk[:, None]
        rel = jax.nn.relu(jnp.einsum('bthd,bsd->bths', qib, k_idx).astype(jnp.float32))
        score = jnp.einsum('bths,bth->bts', rel, wib.astype(jnp.float32))
        score = jnp.where(adm[None], score, -jnp.inf)
        _, sel = lax.top_k(score, top_k)
        kg = k[b_ix, sel]
        vg = v[b_ix, sel]
        logits = jnp.einsum('bthd,btkhd->bhtk', qb, kg).astype(jnp.float32) * scale
        valid = (sel // CHUNK) <= q_chunk[None, :, None]
        logits = jnp.where(valid[:, None], logits, -jnp.inf)
        p = jax.nn.softmax(logits, axis=-1).astype(v.dtype)
        return jnp.einsum('bhtk,btkhd->bthd', p, vg)

    nb = S // Q_BLOCK
    out = lax.map(block, (to_blocks(q), to_blocks(q_idx), to_blocks(w_idx), jnp.arange(nb)))
    return from_blocks(out)


def forgetting_attention(q, k, v, log_f):
    S = q.shape[1]
    scale = HEAD_DIM ** -0.5
    c = jnp.cumsum(log_f, axis=1)
    c_keys = jnp.moveaxis(c, 1, 2)
    key_pos = jnp.arange(S)

    def block(args):
        qb, cb, blk = args
        q_pos = blk * Q_BLOCK + jnp.arange(Q_BLOCK)
        logits = jnp.einsum('bthd,bshd->bhts', qb, k).astype(jnp.float32) * scale
        logits = logits + jnp.moveaxis(cb, 1, 2)[..., None] - c_keys[:, :, None, :]
        causal = key_pos[None, :] <= q_pos[:, None]
        logits = jnp.where(causal, logits, -jnp.inf)
        p = jax.nn.softmax(logits, axis=-1).astype(v.dtype)
        return jnp.einsum('bhts,bshd->bthd', p, v)

    nb = S // Q_BLOCK
    out = lax.map(block, (to_blocks(q), to_blocks(c), jnp.arange(nb)))
    return from_blocks(out)


def even_mixer(h, w_in, b_forget, qn_a, kn_a, qn_b, kn_b, w_out):
    B, S, _ = h.shape
    proj = h @ w_in
    offs = np.cumsum(IN_SPLITS)[:-1].tolist()
    qa, ka, va, qi, ki, wi, qb, kb, vb, fb, gb = jnp.split(proj, offs, axis=-1)

    def heads(t, n, d):
        return t.reshape(B, S, n, d)

    qa = partial_rotary(rms_norm(heads(qa, N_HEADS_A, HEAD_DIM), qn_a), ROT_DIM)
    ka = partial_rotary(rms_norm(heads(ka, N_HEADS_A, HEAD_DIM), kn_a), ROT_DIM)
    va = heads(va, N_HEADS_A, HEAD_DIM)
    qi = partial_rotary(heads(qi, N_IDX_HEADS, IDX_DIM), IDX_ROT_DIM)
    ki = partial_rotary(ki.reshape(B, S, 1, IDX_DIM), IDX_ROT_DIM)[:, :, 0]
    wi = wi * (N_IDX_HEADS * IDX_DIM) ** -0.5
    o_a = dsa_sparse_attention(qa, ka, va, qi, ki, wi)

    qb = rms_norm(heads(qb, N_HEADS_B, HEAD_DIM), qn_b)
    kb = rms_norm(heads(kb, N_HEADS_B, HEAD_DIM), kn_b)
    vb = heads(vb, N_HEADS_B, HEAD_DIM)
    log_f = jax.nn.log_sigmoid(fb.astype(jnp.float32) + b_forget.astype(jnp.float32))
    o_b = forgetting_attention(qb, kb, vb, log_f) * jax.nn.sigmoid(heads(gb, N_HEADS_B, HEAD_DIM))

    o = jnp.concatenate([o_a.reshape(B, S, -1), o_b.reshape(B, S, -1)], axis=-1)
    return o @ w_out


def multiscale_pool_mixer(h, w_pool, pool_scale):
    B, S, D = h.shape
    hf = h.astype(jnp.float32).reshape(B, S, POOL_GROUPS, POOL_WIDTH)
    cs = jnp.concatenate([jnp.zeros_like(hf[:, :1]), jnp.cumsum(hf, axis=1)], axis=1)
    win = jnp.array(POOL_WINDOWS, dtype=jnp.int32)
    t = jnp.arange(S)
    start = jnp.maximum(t[:, None] + 1 - win[None, :], 0)
    window_sum = cs[:, 1:] - cs[:, start, jnp.arange(POOL_GROUPS)[None, :]]
    count = jnp.minimum(t[:, None] + 1, win[None, :]).astype(jnp.float32)
    pooled = window_sum / count[None, :, :, None] - hf
    y = jnp.einsum('bsgc,gcd->bsgd', pooled.astype(h.dtype), w_pool).reshape(B, S, D)
    return y * pool_scale


def swiglu(h, wg, wu, wd):
    return (jax.nn.silu(h @ wg) * (h @ wu)) @ wd


def moe_swiglu(h, router, wg, wu, wd):
    logits = (h @ router).astype(jnp.float32)
    top_vals, top_idx = lax.top_k(logits, TOP_K_EXPERTS)
    gates = jax.nn.softmax(top_vals, axis=-1)
    combine = jnp.sum(jax.nn.one_hot(top_idx, N_EXPERTS, dtype=jnp.float32) * gates[..., None],
                      axis=-2).astype(h.dtype)
    y = jnp.zeros_like(h)
    for e in range(N_EXPERTS):
        y = y + combine[..., e:e + 1] * swiglu(h, wg[e], wu[e], wd[e])
    return y


def setup_inputs(seed: int = 0) -> dict:
    key = jax.random.key(seed)
    ks = jax.random.split(key, 24)
    f32 = jnp.float32

    def nrm(k, shape, scale):
        return jax.random.normal(k, shape, f32) * scale

    def gain(k, shape, s=0.02):
        return 1.0 + s * jax.random.normal(k, shape, f32)

    E, O = N_EVEN, N_ODD
    return {
        "x": nrm(ks[0], (BATCH, SEQ, D_MODEL), 1.0),
        "attn_norm_e": gain(ks[1], (E, D_MODEL)),
        "w_in_e": nrm(ks[2], (E, D_MODEL, IN_DIM), D_MODEL ** -0.5),
        "b_forget_e": jax.random.uniform(ks[3], (E, N_HEADS_B), f32, 1.0, 4.0),
        "q_norm_a_e": gain(ks[4], (E, HEAD_DIM)),
        "k_norm_a_e": gain(ks[5], (E, HEAD_DIM)),
        "q_norm_b_e": gain(ks[6], (E, HEAD_DIM)),
        "k_norm_b_e": gain(ks[7], (E, HEAD_DIM)),
        "w_out_e": nrm(ks[8], (E, D_MODEL, D_MODEL), D_MODEL ** -0.5),
        "ffn_norm_e": gain(ks[9], (E, D_MODEL)),
        "w_gate_e": nrm(ks[10], (E, D_MODEL, D_FF), D_MODEL ** -0.5),
        "w_up_e": nrm(ks[11], (E, D_MODEL, D_FF), D_MODEL ** -0.5),
        "w_down_e": nrm(ks[12], (E, D_FF, D_MODEL), D_FF ** -0.5),
        "pool_norm_o": gain(ks[13], (O, D_MODEL)),
        "w_pool_o": nrm(ks[14], (O, POOL_GROUPS, POOL_WIDTH, POOL_WIDTH), POOL_WIDTH ** -0.5),
        "pool_scale_o": gain(ks[15], (O, D_MODEL), 0.1),
        "moe_norm_o": gain(ks[16], (O, D_MODEL)),
        "router_o": nrm(ks[17], (O, D_MODEL, N_EXPERTS), D_MODEL ** -0.5),
        "w_gate_o": nrm(ks[18], (O, N_EXPERTS, D_MODEL, D_FF_EXPERT), D_MODEL ** -0.5),
        "w_up_o": nrm(ks[19], (O, N_EXPERTS, D_MODEL, D_FF_EXPERT), D_MODEL ** -0.5),
        "w_down_o": nrm(ks[20], (O, N_EXPERTS, D_FF_EXPERT, D_MODEL), D_FF_EXPERT ** -0.5),
    }


def reference(x, attn_norm_e, w_in_e, b_forget_e, q_norm_a_e, k_norm_a_e, q_norm_b_e,
              k_norm_b_e, w_out_e, ffn_norm_e, w_gate_e, w_up_e, w_down_e, pool_norm_o,
              w_pool_o, pool_scale_o, moe_norm_o, router_o, w_gate_o, w_up_o, w_down_o):
    for layer in range(DEPTH):
        i = layer // 2
        if layer % 2 == 0:
            x = x + even_mixer(rms_norm(x, attn_norm_e[i]), w_in_e[i], b_forget_e[i],
                               q_norm_a_e[i], k_norm_a_e[i], q_norm_b_e[i], k_norm_b_e[i],
                               w_out_e[i])
            x = x + swiglu(rms_norm(x, ffn_norm_e[i]), w_gate_e[i], w_up_e[i], w_down_e[i])
        else:
            x = x + multiscale_pool_mixer(rms_norm(x, pool_norm_o[i]), w_pool_o[i], pool_scale_o[i])
            x = x + moe_swiglu(rms_norm(x, moe_norm_o[i]), router_o[i], w_gate_o[i], w_up_o[i],
                               w_down_o[i])
    return x
```

```cpp
#include <hip/hip_runtime.h>
#include <cstdio>
#include <cstdint>

#ifndef MK_ATT_MODES
#define MK_ATT_MODES 3
#endif
#ifndef MK_NAIVE_ATTN
#define MK_NAIVE_ATTN 0
#endif
#ifndef MK_PROBE_HI
#define MK_PROBE_LO 0
#define MK_PROBE_HI 0
#endif
#ifndef MK_FUSED
#define MK_FUSED 1
#endif

#define GAS __attribute__((address_space(1)))
#define LAS __attribute__((address_space(3)))
typedef unsigned short bf16_t;
typedef short bf16x8 __attribute__((ext_vector_type(8)));
typedef float f32x4 __attribute__((ext_vector_type(4)));
typedef float f32x2 __attribute__((ext_vector_type(2)));
typedef float f32x16 __attribute__((ext_vector_type(16)));
typedef unsigned u32x4 __attribute__((ext_vector_type(4)));
typedef unsigned u32x2 __attribute__((ext_vector_type(2)));
typedef int i32x4 __attribute__((ext_vector_type(4)));
typedef int i32x8 __attribute__((ext_vector_type(8)));

extern "C" __device__ int wl_i32(int, int, int) __asm("llvm.amdgcn.writelane.i32");
#define LDS_WAIT() asm volatile("s_waitcnt lgkmcnt(0)" ::: "memory")
#define VM_WAIT() asm volatile("s_waitcnt vmcnt(0)" ::: "memory")

constexpr int S = 8192, DM = 2048, NINP = 8448  , DFF = 5632, DFFE = 7168, NEXP = 8;
constexpr int NH = 8, HD = 128, NIH = 16, IDD = 64, TOPK = 256;
constexpr int MAXSLOT = 18432;
constexpr float RMS_EPS = 1e-6f;
constexpr float ATT_SCALE = 0.08838834764831845f;
constexpr int NWAVES = 8, NTHREADS = 512;

constexpr int C_QA = 0, C_KA = 1024, C_VA = 2048, C_QI = 3072, C_QB = 4096, C_KB = 5120, C_VB = 6144, C_GB = 7168, C_KI = 8192, C_WI = 8256, C_FB = 8272;

constexpr size_t MiB = 1u << 20;
constexpr size_t WS_CTL = 0, CTL_ZERO_BYTES = 32 * 1024;
constexpr size_t WS_WI = 1 * MiB;
constexpr size_t WS_LOGF = 1 * MiB + 512 * 1024;
constexpr size_t WS_CC = 1 * MiB + 768 * 1024;
constexpr size_t WS_TOKE = 2 * MiB;
constexpr size_t WS_TOKG = 2 * MiB + 32 * 1024;
constexpr size_t WS_RSTD3 = 2 * MiB + 96 * 1024;
constexpr size_t WS_SLOT = 2 * MiB + 128 * 1024;
constexpr size_t WS_CNT = 2 * MiB + 192 * 1024;
constexpr size_t WS_TEXP = 2 * MiB + 200 * 1024;
constexpr size_t WS_KI = 3 * MiB;
constexpr size_t WS_QX = 4 * MiB;
constexpr size_t WS_KX = 5 * MiB;
constexpr size_t WS_NQB = 6 * MiB;
constexpr size_t WS_NKB = 6 * MiB + 256 * 1024;
constexpr size_t WS_JLO = 6 * MiB + 512 * 1024;
constexpr size_t WS_ROT = 7 * MiB;
constexpr size_t WS_WIN = 8 * MiB;
constexpr size_t WS_WOUT = 41 * MiB;
constexpr size_t WS_WGU = 49 * MiB;
constexpr size_t WS_WDN = 93 * MiB;
constexpr size_t WS_WPOOL = 115 * MiB;
constexpr size_t WS_MWGU = 117 * MiB;
constexpr size_t WS_MWDN = 565 * MiB;
constexpr size_t WS_BIG1 = 789 * MiB;
constexpr size_t WS_BIG2 = 1045 * MiB;
constexpr size_t WS_ATT = 1189 * MiB;
constexpr size_t WS_MASK = 1319 * MiB;
constexpr size_t WS_O = 1327 * MiB;
constexpr size_t WS_H = 1359 * MiB;
constexpr size_t WS_X1 = 1391 * MiB;
constexpr size_t WS_X2 = 1455 * MiB;
constexpr size_t WS_YMP = 1520 * MiB;
constexpr size_t WS_PART = 1584 * MiB;
constexpr size_t WS_QLIN = 1617 * MiB;
constexpr size_t WS_END = 1618 * MiB;
constexpr int CW_BAR = 4096;

constexpr int RING_BYTES = 131072;
constexpr int MISC_OFF = RING_BYTES + 320;
constexpr int LDS_BYTES = 147456;

__device__ __forceinline__ unsigned cvt_pk_bf16(float lo, float hi) { unsigned r; asm volatile("v_cvt_pk_bf16_f32 %0, %1, %2" : "=v"(r) : "v"(lo), "v"(hi)); return r; }
__device__ __forceinline__ float bf_lo(unsigned w) { return __uint_as_float(w << 16); }
__device__ __forceinline__ float bf_hi(unsigned w) { return __uint_as_float(w & 0xffff0000u); }
__device__ __forceinline__ float bf1(bf16_t b) { return __uint_as_float(((unsigned)b) << 16); }
#define WS_DPP(v, ctrl) __builtin_bit_cast(float, __builtin_amdgcn_update_dpp(0, __builtin_bit_cast(int, (v)), (ctrl), 0xF, 0xF, true))
__device__ __forceinline__ float wave_sum(float v) {
    v += WS_DPP(v, 0xB1);
    v += WS_DPP(v, 0x4E);
    v += WS_DPP(v, 0x141);
    v += WS_DPP(v, 0x140);
    const int iv = __builtin_bit_cast(int, v);
    const float s0 = __builtin_bit_cast(float, __builtin_amdgcn_readlane(iv, 0)), s1 = __builtin_bit_cast(float, __builtin_amdgcn_readlane(iv, 16));
    const float s2 = __builtin_bit_cast(float, __builtin_amdgcn_readlane(iv, 32)), s3 = __builtin_bit_cast(float, __builtin_amdgcn_readlane(iv, 48));
    return (s0 + s1) + (s2 + s3);
}
__device__ __forceinline__ float sigmoidf_(float z) { return 1.f / (1.f + __expf(-z)); }
__device__ __forceinline__ unsigned pk4_fp8(float a, float b, float c, float d) {
    a = __builtin_amdgcn_fmed3f(a, -448.f, 448.f); b = __builtin_amdgcn_fmed3f(b, -448.f, 448.f); c = __builtin_amdgcn_fmed3f(c, -448.f, 448.f); d = __builtin_amdgcn_fmed3f(d, -448.f, 448.f);
    int w = __builtin_amdgcn_cvt_pk_fp8_f32(a, b, 0, false); w = __builtin_amdgcn_cvt_pk_fp8_f32(c, d, w, true); return (unsigned)w; }
constexpr float F8_WSCALE = 512.f, F8_HSCALE = 16.f, F8_ASCALE = 8.f;

#define XB_TMO      128
#define XB_XCNT(j)  (256  + 64 * (j))
#define XB_XSUB(j)  (1280 + 64 * (j))
#define XB_XGEN(j)  (2304 + 64 * (j))
#define XB_TOP      3328
#define XB_TOPGEN   3392
#define XCD_BAR_WORDS 3456
#define XB_SPIN_CAP (1u << 22)

__device__ __forceinline__ unsigned xb_ld(unsigned* p)              { return __hip_atomic_load(p, __ATOMIC_RELAXED, __HIP_MEMORY_SCOPE_AGENT); }
__device__ __forceinline__ unsigned xb_add(unsigned* p, unsigned v) { return __hip_atomic_fetch_add(p, v, __ATOMIC_RELAXED, __HIP_MEMORY_SCOPE_AGENT); }
__device__ __forceinline__ unsigned xb_xcc_id() { return (unsigned)__builtin_amdgcn_s_getreg((3 << 11) | 20) & 0xFu; }
#define XB_SPIN(cond, bar) do { unsigned _sp = 0; while (cond) { __builtin_amdgcn_s_sleep(1); \
    if ((++_sp & 255u) == 0u) { if (xb_ld(&(bar)[XB_TMO])) break; if (_sp > XB_SPIN_CAP) { atomicAdd(&(bar)[XB_TMO], 1u); break; } } } } while (0)

struct XcdBarrier { unsigned* bar; unsigned x; volatile LAS unsigned* st; };

__device__ __forceinline__ XcdBarrier xcd_barrier_post(unsigned* bar, volatile LAS unsigned* st) {
    XcdBarrier b; b.bar = bar; b.x = xb_xcc_id(); b.st = st;
    if (threadIdx.x == 0) (void)xb_add(&bar[XB_XCNT(b.x)], 1u);
    return b;
}
__device__ __forceinline__ void xcd_barrier_complete(unsigned* bar, unsigned x, unsigned& nloc, unsigned& nx) {
    const unsigned G = gridDim.x * gridDim.y * gridDim.z;
    unsigned sum, cnt, mine, sp = 0u;
    for (;;) {
        sum = 0u; cnt = 0u; mine = 0u;
#pragma unroll
        for (unsigned j = 0; j < 16; ++j) { const unsigned c = xb_ld(&bar[XB_XCNT(j)]); sum += c; cnt += (c > 0u) ? 1u : 0u; mine = (j == x) ? c : mine; }
        if (sum == G) break;
        __builtin_amdgcn_s_sleep(1);
        if ((++sp & 255u) == 0u) { if (xb_ld(&bar[XB_TMO])) break; if (sp > XB_SPIN_CAP) { atomicAdd(&bar[XB_TMO], 1u); break; } }
    }
    nloc = mine > 0u ? mine : 1u; nx = cnt > 0u ? cnt : 1u;
}
__device__ __forceinline__ void xcd_barrier(const XcdBarrier& b) {
    asm volatile("s_waitcnt vmcnt(0)" ::: "memory");
    __syncthreads();
    if (threadIdx.x == 0) {
        unsigned* bar = b.bar;
        __builtin_amdgcn_s_waitcnt(0);
        unsigned nloc = b.st[0], nx = b.st[1];
        if (nloc == 0u) { xcd_barrier_complete(bar, b.x, nloc, nx); b.st[0] = nloc; b.st[1] = nx; }
        const unsigned old = xb_add(&bar[XB_XSUB(b.x)], 1u);
        const unsigned gen = old / nloc;
        if (old + 1u == (gen + 1u) * nloc) {
            __builtin_amdgcn_fence(__ATOMIC_RELEASE, "agent");
            asm volatile("s_waitcnt vmcnt(0)" ::: "memory");
            const unsigned og = xb_add(&bar[XB_TOP], 1u);
            const unsigned tg = og / nx;
            if (og + 1u == (tg + 1u) * nx) xb_add(&bar[XB_TOPGEN], 1u);
            else XB_SPIN(xb_ld(&bar[XB_TOPGEN]) == tg, bar);
            __builtin_amdgcn_fence(__ATOMIC_ACQUIRE, "agent");
            xb_add(&bar[XB_XGEN(b.x)], 1u);
            asm volatile("s_waitcnt vmcnt(0)" ::: "memory");
        } else {
            XB_SPIN(xb_ld(&bar[XB_XGEN(b.x)]) == gen, bar);
            __builtin_amdgcn_fence(__ATOMIC_ACQUIRE, "agent");
            asm volatile("s_waitcnt vmcnt(0)" ::: "memory");
        }
    }
    __syncthreads();
}

namespace pg8 {
constexpr int BM = 256, BK = 64, HALF = 128, HTB = HALF * BK * 2, STAGE_BYTES = 8 * HTB, NXCD = 8, WGM = 8;
__host__ __device__ __forceinline__ int lds_byte(int r, int c) { const int st = (r >> 4) * 2 + (c >> 5), rr = r & 15, cc = c & 31, ob = rr * 64 + cc * 2; return st * 1024 + (ob ^ (((ob >> 9) & 1) << 5)); }
__host__ __device__ __forceinline__ void stage_rc(int b, int& R, int& C) { const int st = b / 1024, sb = b % 1024, swz = sb ^ (((sb >> 9) & 1) << 5); R = (st >> 1) * 16 + swz / 64; C = (st & 1) * 32 + (swz % 64) / 2; }
__host__ __device__ __forceinline__ int perm32(int rho) { const int n = rho >> 4, i = rho & 15; return 8 * (i >> 2) + 4 * n + (i & 3); }

__device__ __forceinline__ void glds16_s(const void* sbase, unsigned voff, unsigned lds_dst) {
    unsigned keep;
    asm volatile("s_mov_b32 %0, m0\n\ts_mov_b32 m0, %3\n\ts_nop 0\n\tglobal_load_lds_dwordx4 %1, %2\n\ts_mov_b32 m0, %0" : "=&s"(keep) : "v"(voff), "s"(sbase), "s"(lds_dst) : "memory");
}
struct Unit { int pm, pn; const char* A; const char* B; };

__device__ __forceinline__ bool order_tile(int i, int G, int c, int nM, int nN, int& pm, int& pn) {
    const int nwg = nM * nN; const int L = i * G + c; if (L >= nwg) return false;
    int wgid = L; { const int q = nwg / NXCD, r = nwg % NXCD, xcd = wgid % NXCD, off = wgid / NXCD; wgid = (xcd < r ? xcd * (q + 1) : r * (q + 1) + (xcd - r) * q) + off; }
    const int nig = WGM * nN, gid = wgid / nig, fm = gid * WGM, gsz = (nM - fm) < WGM ? (nM - fm) : WGM;
    pm = fm + ((wgid % nig) % gsz); pn = (wgid % nig) / gsz; return true;
}
struct SchedPlain {
    const char* A0; const char* B0; int nM, nN, G, c; size_t tstep;
    __device__ __forceinline__ bool next(int i, Unit& u) const { if (!order_tile(i, G, c, nM, nN, u.pm, u.pn)) return false; u.A = A0 + (size_t)u.pm * tstep; u.B = B0 + (size_t)u.pn * tstep; return true; }
};
struct SchedPool {
    const char* A0; const char* B0; int nM, nN, G, c; size_t tstep, groupA;
    __device__ __forceinline__ bool next(int i, Unit& u) const { if (!order_tile(i, G, c, nM, nN, u.pm, u.pn)) return false; u.A = A0 + (size_t)(u.pn >> 1) * groupA + (size_t)u.pm * tstep; u.B = B0 + (size_t)u.pn * tstep; return true; }
};
struct ExpCum { int c[7]; __device__ __forceinline__ int expert(int pm) const { int e = 0;
#pragma unroll
        for (int j = 0; j < 7; ++j) e += (pm >= c[j]) ? 1 : 0; return e; } };
struct SchedMoe {
    const char* A0; const char* B0; ExpCum cum; int nM, nN, G, c; size_t tstep, expB; int pm0;
    __device__ __forceinline__ bool next(int i, Unit& u) const { if (!order_tile(i, G, c, nM, nN, u.pm, u.pn)) return false; const int e = cum.expert(u.pm + pm0);
        u.A = A0 + (size_t)u.pm * tstep; u.B = B0 + (size_t)e * expB + (size_t)u.pn * tstep; return true; }
};

struct SchedMoeSplit {
    const char* A0; const char* B0; ExpCum cum; int base, nunits, G, c; size_t tstep, expB, kq_bytes;
    __device__ __forceinline__ bool next(int i, Unit& u) const { const int L = i * G + c; if (L >= nunits) return false;
        const int kq = L & 3, pn = (L >> 2) & 7, loc = L >> 5, pm = base + loc; const int e = cum.expert(pm);
        u.pm = kq * 8 + loc; u.pn = pn; u.A = A0 + (size_t)pm * tstep + (size_t)kq * kq_bytes; u.B = B0 + (size_t)e * expB + (size_t)pn * tstep + (size_t)kq * kq_bytes; return true; }
};

struct EpiStoreBf16 {
    static constexpr bool PERM = true;
    bf16_t* O; int ldc; float scale;
    __device__ __forceinline__ void operator()(const f32x4 (&acc)[2][2][4][2], const Unit& u, int wr, int wc, int fr, int fq) const {
        const int row0 = u.pm * BM + wr * 64 + fr, col0 = u.pn * BM + wc * 32 + 8 * fq;
#pragma unroll
        for (int ai = 0; ai < 2; ++ai)
#pragma unroll
            for (int m = 0; m < 4; ++m) { bf16_t* rowp = O + (size_t)(row0 + ai * HALF + m * 16) * ldc + col0;
#pragma unroll
                for (int bj = 0; bj < 2; ++bj) { const f32x4 v0 = acc[ai][bj][m][0] * scale, v1 = acc[ai][bj][m][1] * scale;
                    u32x4 w; w.x = cvt_pk_bf16(v0[0], v0[1]); w.y = cvt_pk_bf16(v0[2], v0[3]); w.z = cvt_pk_bf16(v1[0], v1[1]); w.w = cvt_pk_bf16(v1[2], v1[3]);
                    *(u32x4*)(rowp + bj * HALF) = w; } }
    }
};
struct EpiInProj {
    static constexpr bool PERM = true;
    bf16_t* O; int ldc; bf16_t* VAo; bf16_t* VBo; bf16_t* GBo;
    __device__ __forceinline__ void operator()(const f32x4 (&acc)[2][2][4][2], const Unit& u, int wr, int wc, int fr, int fq) const {
        const int row0 = u.pm * BM + wr * 64 + fr, seg = u.pn >> 2, scol0 = (u.pn & 3) * BM + wc * 32 + 8 * fq;
        const int kind = (seg == 2 || seg == 6) ? 1 : ((seg == 7) ? 2 : 0);
        bf16_t* const Vb = (seg == 2) ? VAo : VBo;
#pragma unroll
        for (int ai = 0; ai < 2; ++ai)
#pragma unroll
            for (int m = 0; m < 4; ++m) { const int row = row0 + ai * HALF + m * 16;
#pragma unroll
                for (int bj = 0; bj < 2; ++bj) { f32x4 v0 = acc[ai][bj][m][0], v1 = acc[ai][bj][m][1]; const int sc = scol0 + bj * HALF;
                    bf16_t* p;
                    if (kind == 1) p = Vb + ((size_t)(sc >> 7) * S + row) * HD + (sc & 127);
                    else if (kind == 2) { p = GBo + (size_t)row * 1024 + sc;
#pragma unroll
                        for (int j = 0; j < 4; ++j) { v0[j] = __builtin_amdgcn_rcpf(1.f + __builtin_amdgcn_exp2f(-1.4426950408889634f * v0[j])); v1[j] = __builtin_amdgcn_rcpf(1.f + __builtin_amdgcn_exp2f(-1.4426950408889634f * v1[j])); } }
                    else p = O + (size_t)row * ldc + u.pn * BM + bj * HALF + wc * 32 + 8 * fq;
                    u32x4 w; w.x = cvt_pk_bf16(v0[0], v0[1]); w.y = cvt_pk_bf16(v0[2], v0[3]); w.z = cvt_pk_bf16(v1[0], v1[1]); w.w = cvt_pk_bf16(v1[2], v1[3]);
                    *(u32x4*)p = w; } }
    }
};
struct EpiSwiglu {
    static constexpr bool PERM = true;
    bf16_t* O; int ldc;
    __device__ __forceinline__ void operator()(const f32x4 (&acc)[2][2][4][2], const Unit& u, int wr, int wc, int fr, int fq) const {
        const int row0 = u.pm * BM + wr * 64 + fr, col0 = u.pn * HALF + wc * 32 + 8 * fq;
#pragma unroll
        for (int ai = 0; ai < 2; ++ai)
#pragma unroll
            for (int m = 0; m < 4; ++m) { bf16_t* rowp = O + (size_t)(row0 + ai * HALF + m * 16) * ldc + col0;
                f32x4 v[2];
#pragma unroll
                for (int n = 0; n < 2; ++n) { const f32x4 g = acc[ai][0][m][n], up = acc[ai][1][m][n];
#pragma unroll
                    for (int j = 0; j < 4; ++j) { const float e = __builtin_amdgcn_exp2f(-1.4426950408889634f * g[j]); v[n][j] = g[j] * __builtin_amdgcn_rcpf(1.f + e) * up[j]; } }
                u32x4 w; w.x = cvt_pk_bf16(v[0][0], v[0][1]); w.y = cvt_pk_bf16(v[0][2], v[0][3]); w.z = cvt_pk_bf16(v[1][0], v[1][1]); w.w = cvt_pk_bf16(v[1][2], v[1][3]);
                *(u32x4*)rowp = w; }
    }
};
struct EpiSwigluF8 {
    static constexpr bool PERM = true;
    unsigned char* O; int ldc; float sin_, sout;
    __device__ __forceinline__ void operator()(const f32x4 (&acc)[2][2][4][2], const Unit& u, int wr, int wc, int fr, int fq) const {
        const int row0 = u.pm * BM + wr * 64 + fr, col0 = u.pn * HALF + wc * 32 + 8 * fq;
#pragma unroll
        for (int ai = 0; ai < 2; ++ai)
#pragma unroll
            for (int m = 0; m < 4; ++m) { unsigned char* rowp = O + (size_t)(row0 + ai * HALF + m * 16) * ldc + col0;
                f32x4 v[2];
#pragma unroll
                for (int n = 0; n < 2; ++n) { const f32x4 g = acc[ai][0][m][n] * sin_, up = acc[ai][1][m][n] * (sin_ * sout);
#pragma unroll
                    for (int j = 0; j < 4; ++j) { const float e = __builtin_amdgcn_exp2f(-1.4426950408889634f * g[j]); v[n][j] = g[j] * __builtin_amdgcn_rcpf(1.f + e) * up[j]; } }
                u32x2 w; w.x = pk4_fp8(v[0][0], v[0][1], v[0][2], v[0][3]); w.y = pk4_fp8(v[1][0], v[1][1], v[1][2], v[1][3]);
                *(u32x2*)rowp = w; }
    }
};
struct EpiResid {
    static constexpr bool PERM = false;
    const float* res; float* out; int ldc; const float* cscale; float ascale;
    __device__ __forceinline__ void operator()(const f32x4 (&acc)[2][2][4][2], const Unit& u, int wr, int wc, int fr, int fq) const {
        const int row0 = u.pm * BM + wr * 64 + fr, col0 = u.pn * BM + wc * 32 + 4 * fq;
        f32x4 cs[2][2];
#pragma unroll
        for (int bj = 0; bj < 2; ++bj)
#pragma unroll
            for (int n = 0; n < 2; ++n) cs[bj][n] = (cscale ? *(const f32x4*)(cscale + col0 + bj * HALF + n * 16) : (f32x4){1.f, 1.f, 1.f, 1.f}) * ascale;
#pragma unroll
        for (int ai = 0; ai < 2; ++ai)
#pragma unroll
            for (int m = 0; m < 4; ++m) { const size_t off = (size_t)(row0 + ai * HALF + m * 16) * ldc + col0;
#pragma unroll
                for (int bj = 0; bj < 2; ++bj)
#pragma unroll
                    for (int n = 0; n < 2; ++n) { f32x4 v = acc[ai][bj][m][n] * cs[bj][n];
                        if (res) v += *(const f32x4*)(res + off + bj * HALF + n * 16);
                        *(f32x4*)(out + off + bj * HALF + n * 16) = v; }
                asm volatile("" ::: "memory"); }
    }
};

template <class Epi, class Sched, bool FP8 = false>
__device__ __forceinline__ void gemm_phase(LAS unsigned char* lds, const int Kb, const int nt  , const Sched& S, const Epi& E) {
    const int tid = threadIdx.x, wid = __builtin_amdgcn_readfirstlane(tid >> 6), lane = tid & 63, wr = wid >> 2, wc = wid & 3, fr = lane & 15, fq = lane >> 4;
    unsigned voffA, voffB;
    { int R, C; stage_rc(tid * 16, R, C); const int Rb = Epi::PERM ? ((R & ~31) + perm32(R & 31)) : R;
        voffA = (unsigned)(R * Kb + C * 2); voffB = (unsigned)(Rb * Kb + C * 2); }
    const size_t r64 = (size_t)64 * Kb;
    const size_t kstep = (size_t)(BK * 2);
    const size_t hstep = (size_t)HALF * Kb;
    const unsigned ldsw = (unsigned)wid * 1024u, ldsb = (unsigned)(uintptr_t)lds;
    const int aoff = lds_byte(wr * 64 + fr, fq * 8), boff = lds_byte(wc * 32 + fr, fq * 8);
#define PG8_SA(b, h) (((b) * 2 + (h)) * HTB)
#define PG8_SB(b, h) ((4 + (b) * 2 + (h)) * HTB)
#define PG8_STAGE(bufoff, gbase, voff) do { _Pragma("unroll") for (int _i = 0; _i < 2; ++_i) glds16_s((const void*)((const char*)(gbase) + _i * r64), (voff), ldsb + (unsigned)(bufoff) + ldsw + _i * 8192u); } while (0)
#define PG8_LD16(off) (*(const LAS bf16x8*)(lds + (off)))
#define PG8_CAT8(o_) __builtin_shufflevector(__builtin_bit_cast(i32x4, PG8_LD16(o_)), __builtin_bit_cast(i32x4, PG8_LD16((o_) + 1024)), 0, 1, 2, 3, 4, 5, 6, 7)
#define PG8_LDA(b, h) do { _Pragma("unroll") for (int m = 0; m < 4; ++m) { const int o_ = PG8_SA(b, h) + aoff + m * 2048; \
        if constexpr (FP8) A8[m] = PG8_CAT8(o_); else { At[m][0] = PG8_LD16(o_); At[m][1] = PG8_LD16(o_ + 1024); } } } while (0)
#define PG8_LDB(X, X8, b, h) do { _Pragma("unroll") for (int n = 0; n < 2; ++n) { const int o_ = PG8_SB(b, h) + boff + n * 2048; \
        if constexpr (FP8) X8[n] = PG8_CAT8(o_); else { X[n][0] = PG8_LD16(o_); X[n][1] = PG8_LD16(o_ + 1024); } } } while (0)
#define PG8_MMA(ai, bj, X, X8) do { if constexpr (!FP8) __builtin_amdgcn_s_setprio(1); _Pragma("unroll") for (int m = 0; m < 4; ++m) _Pragma("unroll") for (int n = 0; n < 2; ++n) { \
        if constexpr (FP8) acc[ai][bj][m][n] = __builtin_amdgcn_mfma_scale_f32_16x16x128_f8f6f4(X8[n], A8[m], acc[ai][bj][m][n], 0, 0, 0, 0x7f7f7f7f, 0, 0x7f7f7f7f); \
        else { _Pragma("unroll") for (int k = 0; k < 2; ++k) acc[ai][bj][m][n] = __builtin_amdgcn_mfma_f32_16x16x32_bf16(X[n][k], At[m][k], acc[ai][bj][m][n], 0, 0, 0); } } \
        if constexpr (!FP8) __builtin_amdgcn_s_setprio(0); } while (0)
#define PG8_WAIT_V(n) asm volatile("s_waitcnt vmcnt(" #n ")" ::: "memory")
#define PG8_WAIT_L(n) asm volatile("s_waitcnt lgkmcnt(" #n ")" ::: "memory")
#define PG8_BAR __builtin_amdgcn_s_barrier()
#define PG8_SCHED __builtin_amdgcn_sched_barrier(0)
#define PG8_HI do { if constexpr (FP8) asm volatile("s_setprio 1"); } while (0)
#define PG8_LO do { if constexpr (FP8) asm volatile("s_setprio 0"); } while (0)
    Unit cur, nxt; int ui = 0;
    if (!S.next(0, cur)) return;
    f32x4 acc[2][2][4][2];
#pragma unroll
    for (int a = 0; a < 2; ++a)
#pragma unroll
        for (int b = 0; b < 2; ++b)
#pragma unroll
            for (int m = 0; m < 4; ++m)
#pragma unroll
                for (int n = 0; n < 2; ++n) acc[a][b][m][n] = (f32x4){0.f, 0.f, 0.f, 0.f};
    bf16x8 At[4][2], B0[2][2], B1[2][2]; i32x8 A8[4], B08[2], B18[2];
    const char* cA = cur.A; const char* cB = cur.B;
    PG8_STAGE(PG8_SB(0, 0), cB, voffB); PG8_STAGE(PG8_SA(0, 0), cA, voffA); PG8_STAGE(PG8_SB(0, 1), cB + hstep, voffB); PG8_STAGE(PG8_SA(0, 1), cA + hstep, voffA);
    if (wr == 1) PG8_BAR;
    PG8_WAIT_V(4); PG8_BAR;
    PG8_STAGE(PG8_SB(1, 0), cB + kstep, voffB); PG8_STAGE(PG8_SA(1, 0), cA + kstep, voffA); PG8_STAGE(PG8_SB(1, 1), cB + hstep + kstep, voffB);
    PG8_WAIT_V(6); PG8_BAR;
    for (;;) {
        const bool has_next = S.next(ui + 1, nxt);
        const char* nA = has_next ? nxt.A : cA; const char* nB = has_next ? nxt.B : cB;
        for (int t = 0; t < nt; t += 2) {
            const bool last = (t == nt - 2);
            const char* a1 = cA + (size_t)(t + 1) * kstep;
            const char* a2 = last ? nA : cA + (size_t)(t + 2) * kstep; const char* b2 = last ? nB : cB + (size_t)(t + 2) * kstep;
            const char* a3 = a2 + kstep; const char* b3 = b2 + kstep;
            PG8_LDB(B0, B08, 0, 0); PG8_SCHED; PG8_LDA(0, 0); PG8_STAGE(PG8_SA(1, 1), a1 + hstep, voffA);
            PG8_WAIT_L(8); PG8_BAR; PG8_HI; PG8_WAIT_L(0); PG8_MMA(0, 0, B0, B08); PG8_BAR; PG8_LO; PG8_SCHED;
            PG8_LDB(B1, B18, 0, 1); PG8_STAGE(PG8_SB(0, 0), b2, voffB);
            PG8_BAR; PG8_HI; PG8_WAIT_L(0); PG8_MMA(0, 1, B1, B18); PG8_BAR; PG8_LO;
            PG8_LDA(0, 1); PG8_STAGE(PG8_SA(0, 0), a2, voffA);
            PG8_BAR; PG8_HI; PG8_WAIT_L(0); PG8_MMA(1, 0, B0, B08); PG8_BAR; PG8_LO; PG8_SCHED;
            PG8_STAGE(PG8_SB(0, 1), b2 + hstep, voffB);
            PG8_WAIT_V(6); PG8_BAR; PG8_HI; PG8_MMA(1, 1, B1, B18); PG8_BAR; PG8_LO;
            PG8_LDB(B0, B08, 1, 0); PG8_SCHED; PG8_LDA(1, 0); PG8_STAGE(PG8_SA(0, 1), a2 + hstep, voffA);
            PG8_WAIT_L(8); PG8_BAR; PG8_HI; PG8_WAIT_L(0); PG8_MMA(0, 0, B0, B08); PG8_BAR; PG8_LO; PG8_SCHED;
            PG8_LDB(B1, B18, 1, 1); PG8_STAGE(PG8_SB(1, 0), b3, voffB);
            PG8_BAR; PG8_HI; PG8_WAIT_L(0); PG8_MMA(0, 1, B1, B18); PG8_BAR; PG8_LO;
            PG8_LDA(1, 1); PG8_STAGE(PG8_SA(1, 0), a3, voffA);
            PG8_BAR; PG8_HI; PG8_WAIT_L(0); PG8_MMA(1, 0, B0, B08); PG8_BAR; PG8_LO; PG8_SCHED;
            PG8_STAGE(PG8_SB(1, 1), b3 + hstep, voffB);
            PG8_WAIT_V(6); PG8_BAR; PG8_HI; PG8_MMA(1, 1, B1, B18); PG8_BAR; PG8_LO;
        }
        { int l_; asm volatile("v_mbcnt_lo_u32_b32 %0, -1, 0\n\tv_mbcnt_hi_u32_b32 %0, -1, %0" : "=v"(l_));
          E(acc, cur, wr, wc, l_ & 15, l_ >> 4); }
        if (!has_next) break;
#pragma unroll
        for (int a = 0; a < 2; ++a)
#pragma unroll
            for (int b = 0; b < 2; ++b)
#pragma unroll
                for (int m = 0; m < 4; ++m)
#pragma unroll
                    for (int n = 0; n < 2; ++n) acc[a][b][m][n] = (f32x4){0.f, 0.f, 0.f, 0.f};
        cur = nxt; cA = nA; cB = nB; ++ui;
    }
    PG8_WAIT_V(0);
    if (wr == 0) PG8_BAR;
    PG8_BAR;
#undef PG8_SA
#undef PG8_SB
#undef PG8_STAGE
#undef PG8_LDA
#undef PG8_LDB
#undef PG8_MMA
#undef PG8_CAT8
#undef PG8_LD16
#undef PG8_WAIT_V
#undef PG8_WAIT_L
#undef PG8_BAR
#undef PG8_SCHED
#undef PG8_HI
#undef PG8_LO
}
}


namespace fa {
constexpr int QBLK = 32, KVBLK = 64, QB = 256, D = 128;
constexpr int SHM_V = 16384, SHM_K = 16384, SHM_X = 2048;
constexpr int OFF_V = 0, OFF_K = 2 * SHM_V, OFF_X = OFF_K + 2 * SHM_K, OFF_W = OFF_X + 2 * SHM_X;
constexpr float SCALE = 0.08838834764831845f, THR = 8.f;
typedef short s16x4 __attribute__((ext_vector_type(4)));
#define KSWZ(row, colB) ((row) * 256 + ((colB) ^ (((row) & 7) << 4)))
#define SBAR() __builtin_amdgcn_sched_barrier(0)
__device__ __forceinline__ int v_st(int k, int c) { const int kk = (k & ~0xC) | ((k & 4) << 1) | ((k & 8) >> 1); return ((kk >> 3) * 4 + (c >> 5)) * 512 + ((kk & 7) * 32 + (c & 31)) * 2; }
__device__ __forceinline__ int v_rd_base(int lane) { return ((lane & 3) << 3) | (((lane >> 2) & 3) << 6) | (((lane >> 4) & 1) << 5) | (((lane >> 5) & 1) << 8); }
constexpr int v_rd_off(int d0, int ks, int half) { return d0 * 512 + ks * 4096 + half * 2048; }
__device__ __forceinline__ int crow(int r, int hi) { return (r & 3) + 8 * (r >> 2) + 4 * hi; }
__device__ __forceinline__ void mask_causal(f32x16& p0, f32x16& p1, int dq) {
    const float NEG = -__builtin_inff();
#pragma unroll
    for (int r = 0; r < 16; ++r) { const int c = (r & 3) + 8 * (r >> 2); if (dq - c < 0) p0[r] = NEG; if (dq - c - 32 < 0) p1[r] = NEG; }
}
__device__ __forceinline__ void mask_bits(f32x16& p0, f32x16& p1, unsigned long long mw, int hi) {
    const unsigned lo = (unsigned)mw >> (4 * hi), hw = (unsigned)(mw >> 32) >> (4 * hi);
#pragma unroll
    for (int r = 0; r < 16; ++r) { const int c = (r & 3) + 8 * (r >> 2);
        const unsigned t0 = (unsigned)((int)(lo << (31 - c)) >> 31), t1 = (unsigned)((int)(hw << (31 - c)) >> 31);
        p0[r] = __uint_as_float((__float_as_uint(p0[r]) & t0) | (0xFF800000u & ~t0));
        p1[r] = __uint_as_float((__float_as_uint(p1[r]) & t1) | (0xFF800000u & ~t1)); }
}
__device__ __forceinline__ void partialSM(f32x16& p0, f32x16& p1, float& m_reg, float& mn, float& alpha) {
    float pmax = p0[0]; for (int r = 1; r < 16; ++r) pmax = fmaxf(pmax, p0[r]); for (int r = 0; r < 16; ++r) pmax = fmaxf(pmax, p1[r]);
    { auto rr = __builtin_amdgcn_permlane32_swap(__float_as_uint(pmax), __float_as_uint(pmax), false, false);
      pmax = fmaxf(__uint_as_float(rr[0]), __uint_as_float(rr[1])); }
    constexpr float C2 = 1.4426950408889634f * SCALE;
    if (__builtin_expect(__all((pmax - m_reg) * SCALE <= THR), 1)) { mn = m_reg; alpha = 1.f; }
    else { mn = fmaxf(m_reg, pmax); alpha = __builtin_amdgcn_exp2f((m_reg - mn) * C2); m_reg = mn; }
    const float mnL = -mn * C2;
    for (int r = 0; r < 16; ++r) p0[r] = fmaf(p0[r], C2, mnL); for (int r = 0; r < 16; ++r) p1[r] = fmaf(p1[r], C2, mnL);
    for (int r = 0; r < 16; ++r) p0[r] = __builtin_amdgcn_exp2f(p0[r]);
}
__device__ __forceinline__ void finishSM(f32x16& p0, f32x16& p1, float alpha, float& l_reg, bf16x8& pa0, bf16x8& pa1, bf16x8& pa2, bf16x8& pa3) {
    for (int r = 0; r < 16; ++r) p1[r] = __builtin_amdgcn_exp2f(p1[r]);
    float ps = 0; for (int r = 0; r < 16; ++r) ps += p0[r]; for (int r = 0; r < 16; ++r) ps += p1[r];
    { auto rr = __builtin_amdgcn_permlane32_swap(__float_as_uint(ps), __float_as_uint(ps), false, false);
      ps = __uint_as_float(rr[0]) + __uint_as_float(rr[1]); }
    l_reg = l_reg * alpha + ps;
#define PK4(P, B_, OUT) do { unsigned a0 = cvt_pk_bf16(P[B_+0], P[B_+1]), a1 = cvt_pk_bf16(P[B_+2], P[B_+3]);                          \
        unsigned b0 = cvt_pk_bf16(P[B_+4], P[B_+5]), b1 = cvt_pk_bf16(P[B_+6], P[B_+7]);                                             \
        auto r0 = __builtin_amdgcn_permlane32_swap(a0, b0, false, false); auto r1 = __builtin_amdgcn_permlane32_swap(a1, b1, false, false); \
        u32x4 w = {r0[0], r1[0], r0[1], r1[1]}; OUT = *reinterpret_cast<bf16x8*>(&w); } while (0)
    PK4(p0, 0, pa0); PK4(p0, 8, pa1); PK4(p1, 0, pa2); PK4(p1, 8, pa3);
#undef PK4
}
template <int KB, bool EXT>
__device__ __forceinline__ void qkt(f32x16& p0, f32x16& p1, const char* lds, int r32, int hi, const bf16x8* qr, bf16x8 qx) {
    p0 = f32x16{}; p1 = f32x16{};
    const char* kb[4];
#pragma unroll
    for (int dd = 0; dd < 4; ++dd) kb[dd] = lds + OFF_K + KB * SHM_K + KSWZ(r32, (dd * 16 + hi * 8) * 2);
#pragma unroll
    for (int d0 = 0; d0 < 8; ++d0) { const char* a = kb[d0 & 3] + (d0 >> 2) * 128;
        bf16x8 b0 = *reinterpret_cast<const bf16x8*>(a);
        bf16x8 b1 = *reinterpret_cast<const bf16x8*>(a + 32 * 256);
        p0 = __builtin_amdgcn_mfma_f32_32x32x16_bf16(b0, qr[d0], p0, 0, 0, 0);
        p1 = __builtin_amdgcn_mfma_f32_32x32x16_bf16(b1, qr[d0], p1, 0, 0, 0); }
    if (EXT) { const char* xa = lds + OFF_X + KB * SHM_X + r32 * 32 + hi * 16;
        bf16x8 x0 = *reinterpret_cast<const bf16x8*>(xa), x1 = *reinterpret_cast<const bf16x8*>(xa + 32 * 32);
        p0 = __builtin_amdgcn_mfma_f32_32x32x16_bf16(x0, qx, p0, 0, 0, 0);
        p1 = __builtin_amdgcn_mfma_f32_32x32x16_bf16(x1, qx, p1, 0, 0, 0); }
}
template <int VB>
__device__ __forceinline__ void pv_tile(f32x16* o, int vb0, bf16x8 pa0, bf16x8 pa1, bf16x8 pa2, bf16x8 pa3) {
#define TRRD(dst, off) asm volatile("ds_read_b64_tr_b16 %0, %1 offset:%2" : "=&v"(dst) : "v"(vb0), "i"(off) : "memory")
#define PV_D0(d0) do { s16x4 l0, l1, l2, l3, h0, h1, h2, h3; constexpr int b_ = OFF_V + VB * SHM_V + v_rd_off(d0, 0, 0); \
        TRRD(l0, b_); TRRD(h0, b_ + 2048); TRRD(l1, b_ + 4096); TRRD(h1, b_ + 6144); TRRD(l2, b_ + 8192); TRRD(h2, b_ + 10240); TRRD(l3, b_ + 12288); TRRD(h3, b_ + 14336); \
        asm volatile("s_waitcnt lgkmcnt(0)" ::: "memory"); SBAR();   \
        o[d0] = __builtin_amdgcn_mfma_f32_32x32x16_bf16(pa0, (bf16x8){l0[0], l0[1], l0[2], l0[3], h0[0], h0[1], h0[2], h0[3]}, o[d0], 0, 0, 0);   \
        o[d0] = __builtin_amdgcn_mfma_f32_32x32x16_bf16(pa1, (bf16x8){l1[0], l1[1], l1[2], l1[3], h1[0], h1[1], h1[2], h1[3]}, o[d0], 0, 0, 0);   \
        o[d0] = __builtin_amdgcn_mfma_f32_32x32x16_bf16(pa2, (bf16x8){l2[0], l2[1], l2[2], l2[3], h2[0], h2[1], h2[2], h2[3]}, o[d0], 0, 0, 0);   \
        o[d0] = __builtin_amdgcn_mfma_f32_32x32x16_bf16(pa3, (bf16x8){l3[0], l3[1], l3[2], l3[3], h3[0], h3[1], h3[2], h3[3]}, o[d0], 0, 0, 0); } while (0)
    PV_D0(0); PV_D0(1); PV_D0(2); PV_D0(3);
#undef PV_D0
#undef TRRD
}
template <int MODE>
__device__ __forceinline__ void attn_block(char* lds, const bf16_t* Qh  , const float* qgain, const float* rot, const bf16_t* Kh, const bf16_t* Vh, const bf16_t* QXh, const bf16_t* KXh,
                                           const unsigned long long* mrow, const bf16_t* gate, bf16_t* Ob, int ocol0, int hoff, int P0,
                                           int jb, int je, float* part, float* pml) {
    int lane; asm volatile("v_mbcnt_lo_u32_b32 %0, -1, 0\n\tv_mbcnt_hi_u32_b32 %0, -1, %0" : "=v"(lane));
    const int wid = __builtin_amdgcn_readfirstlane(threadIdx.x >> 6), tid = wid * 64 + lane, r32 = lane & 31, hi = lane >> 5;
    const int qlo = P0 + wid * QBLK, qm = qlo + r32 - 4 * hi, lastj = qlo / KVBLK;
    float* wsw = (float*)(lds + OFF_W) + wid * 64; float* li_l = wsw; float* al_l = wsw + 32;
    const int vb0 = (int)(uintptr_t)lds + v_rd_base(lane);
    const unsigned ldsb = (unsigned)(uintptr_t)lds;
    bf16x8 qr[8];
    { const bf16_t* qrow = Qh + (size_t)(qlo + r32) * NINP + hi * 8; float qv[8][8]; float ss = 0.f;
#pragma unroll
      for (int d0 = 0; d0 < 8; ++d0) { const u32x4 w = *reinterpret_cast<const u32x4*>(qrow + d0 * 16);
          qv[d0][0] = bf_lo(w.x); qv[d0][1] = bf_hi(w.x); qv[d0][2] = bf_lo(w.y); qv[d0][3] = bf_hi(w.y); qv[d0][4] = bf_lo(w.z); qv[d0][5] = bf_hi(w.z); qv[d0][6] = bf_lo(w.w); qv[d0][7] = bf_hi(w.w);
#pragma unroll
          for (int j = 0; j < 8; ++j) ss = fmaf(qv[d0][j], qv[d0][j], ss); }
      { auto rr = __builtin_amdgcn_permlane32_swap(__float_as_uint(ss), __float_as_uint(ss), false, false); ss = __uint_as_float(rr[0]) + __uint_as_float(rr[1]); }
      const float rstd = 1.f / sqrtf(ss * (1.f / HD) + RMS_EPS);
#pragma unroll
      for (int d0 = 0; d0 < 8; ++d0) { const f32x4 g0 = *(const f32x4*)(qgain + d0 * 16 + hi * 8), g1 = *(const f32x4*)(qgain + d0 * 16 + hi * 8 + 4);
#pragma unroll
          for (int j = 0; j < 4; ++j) { qv[d0][j] *= rstd * g0[j]; qv[d0][4 + j] *= rstd * g1[j]; } }
      if (MODE == 0) { const float* rp = rot + ((size_t)(qlo + r32) * 16 + hi * 8) * 2;
#pragma unroll
          for (int j = 0; j < 8; j += 2) { const f32x4 cs = *(const f32x4*)(rp + 2 * j);
              { const float x1 = qv[0][j], x2 = qv[1][j]; qv[0][j] = x1 * cs[0] - x2 * cs[1]; qv[1][j] = x2 * cs[0] + x1 * cs[1]; }
              { const float x1 = qv[0][j + 1], x2 = qv[1][j + 1]; qv[0][j + 1] = x1 * cs[2] - x2 * cs[3]; qv[1][j + 1] = x2 * cs[2] + x1 * cs[3]; } } }
#pragma unroll
      for (int d0 = 0; d0 < 8; ++d0) { u32x4 w; w.x = cvt_pk_bf16(qv[d0][0], qv[d0][1]); w.y = cvt_pk_bf16(qv[d0][2], qv[d0][3]); w.z = cvt_pk_bf16(qv[d0][4], qv[d0][5]); w.w = cvt_pk_bf16(qv[d0][6], qv[d0][7]);
          qr[d0] = *reinterpret_cast<bf16x8*>(&w); } }
    bf16x8 qx = (bf16x8){0, 0, 0, 0, 0, 0, 0, 0};
    if (MODE == 1 && hi == 0) qx = *reinterpret_cast<const bf16x8*>(QXh + (size_t)(qlo + r32) * 8);
    unsigned koff[2], voff[2];
#pragma unroll
    for (int i = 0; i < 2; ++i) { const int q = tid * 16 + i * 8192;
        { const int row = q >> 8, colB = (q & 255) ^ ((row & 7) << 4); koff[i] = (unsigned)(row * 256 + colB); }
        { const int sb = q >> 9, w = q & 511, kk = (sb >> 2) * 8 + (w >> 6), k = (kk & ~0xC) | ((kk & 4) << 1) | ((kk & 8) >> 1), col = (sb & 3) * 32 + ((w & 63) >> 4) * 8; voff[i] = (unsigned)(k * 256 + col * 2); } }
#define KDMA(k0, bf) do { const bf16_t* kb_ = Kh + (size_t)(k0) * D; _Pragma("unroll") for (int i_ = 0; i_ < 2; ++i_) pg8::glds16_s((const void*)kb_, koff[i_], ldsb + OFF_K + (bf) * SHM_K + wid * 1024 + i_ * 8192); } while (0)
#define VDMA(k0, bf) do { const bf16_t* vb_ = Vh + (size_t)(k0) * D; _Pragma("unroll") for (int i_ = 0; i_ < 2; ++i_) pg8::glds16_s((const void*)vb_, voff[i_], ldsb + OFF_V + (bf) * SHM_V + wid * 1024 + i_ * 8192); } while (0)
    const unsigned mo = (unsigned)(qlo + r32) * 1024u;
#define MLOAD(t_) (*(const unsigned long long*)((const char*)(mrow + (t_)) + mo))
    float m_reg = -1e30f, l_reg = 0.f; f32x16 o[4] = {};
#define RESC(a) do { if (__any((a) < 1.f)) { if (hi == 0) al_l[r32] = (a); asm volatile("s_waitcnt lgkmcnt(0)" ::: "memory");              \
                     for (int d_ = 0; d_ < 4; ++d_) for (int r = 0; r < 16; ++r) o[d_][r] *= al_l[crow(r, hi)]; } } while (0)
    __syncthreads();
    if constexpr (MODE == 0) {
#define ACT(t) ((t) <= lastj)
        unsigned long long mw;
        f32x16 pA0, pA1, pB0, pB1; float mnA = 0.f, mnB = 0.f, alA = 1.f, alB = 1.f; bf16x8 pa0, pa1, pa2, pa3;
        const int NTr = je - jb;
        KDMA(jb * KVBLK, 0); VM_WAIT(); __syncthreads();
        mw = MLOAD(jb); KDMA((jb + 1) * KVBLK, 1); VDMA(jb * KVBLK, 0);
        if (ACT(jb)) { qkt<0, false>(pA0, pA1, lds, r32, hi, qr, qx); mask_bits(pA0, pA1, mw, hi); partialSM(pA0, pA1, m_reg, mnA, alA); }
        VM_WAIT(); __syncthreads();
#define HALF(PX0, PX1, mnX, alX, PY0, PY1, alY, t, KB, VB) do { \
        mw = MLOAD(t); if ((t) + 1 < je) KDMA(((t) + 1) * KVBLK, (KB) ^ 1); VDMA((t) * KVBLK, KB); \
        SBAR(); if (ACT(t)) qkt<KB, false>(PX0, PX1, lds, r32, hi, qr, qx); \
        if (ACT((t) - 1)) finishSM(PY0, PY1, alY, l_reg, pa0, pa1, pa2, pa3); SBAR(); \
        if (ACT((t) - 1)) pv_tile<VB>(o, vb0, pa0, pa1, pa2, pa3); \
        if (ACT(t)) { mask_bits(PX0, PX1, mw, hi); partialSM(PX0, PX1, m_reg, mnX, alX); RESC(alX); } \
        VM_WAIT(); __syncthreads(); } while (0)
#define HALFU(PX0, PX1, mnX, alX, PY0, PY1, alY, t, KB, VB) do { \
        mw = MLOAD(t); if ((t) + 1 < je) KDMA(((t) + 1) * KVBLK, (KB) ^ 1); VDMA((t) * KVBLK, KB); \
        SBAR(); qkt<KB, false>(PX0, PX1, lds, r32, hi, qr, qx); \
        finishSM(PY0, PY1, alY, l_reg, pa0, pa1, pa2, pa3); SBAR(); \
        pv_tile<VB>(o, vb0, pa0, pa1, pa2, pa3); \
        mask_bits(PX0, PX1, mw, hi); partialSM(PX0, PX1, m_reg, mnX, alX); RESC(alX); \
        VM_WAIT(); __syncthreads(); } while (0)
        const int tdiag = P0 / KVBLK; int r = 1;
        for (; r + 1 < NTr && jb + r + 1 <= tdiag; r += 2) {
            HALFU(pB0, pB1, mnB, alB, pA0, pA1, alA, jb + r, 1, 0);
            HALFU(pA0, pA1, mnA, alA, pB0, pB1, alB, jb + r + 1, 0, 1);
        }
        for (; r + 1 < NTr; r += 2) {
            HALF(pB0, pB1, mnB, alB, pA0, pA1, alA, jb + r, 1, 0);
            HALF(pA0, pA1, mnA, alA, pB0, pB1, alB, jb + r + 1, 0, 1);
        }
#undef HALFU
        HALF(pB0, pB1, mnB, alB, pA0, pA1, alA, je - 1, 1, 0);
        if (ACT(je - 1)) { finishSM(pB0, pB1, alB, l_reg, pa0, pa1, pa2, pa3); SBAR(); pv_tile<1>(o, vb0, pa0, pa1, pa2, pa3); }
#undef HALF
#undef ACT
    } else {
        bf16x8 st_x = (bf16x8){0, 0, 0, 0, 0, 0, 0, 0};
        const int xkey = tid >> 1, xhalf = tid & 1; const unsigned xo = (unsigned)xkey * 16u;
#define XLOAD(k0) do { if (tid < 128 && xhalf == 0) st_x = *reinterpret_cast<const bf16x8*>((const char*)(KXh + (size_t)(k0) * 8) + xo); } while (0)
#define XWRITE(bf) do { if (tid < 128) *(bf16x8*)(lds + OFF_X + (bf) * SHM_X + xkey * 32 + xhalf * 16) = st_x; } while (0)
        KDMA(jb * KVBLK, 0); VDMA(jb * KVBLK, 0); XLOAD(jb * KVBLK); VM_WAIT(); XWRITE(0); __syncthreads();
#define STEP(t, BUF) do { \
        if ((t) + 1 < je) { KDMA(((t) + 1) * KVBLK, (BUF) ^ 1); VDMA(((t) + 1) * KVBLK, (BUF) ^ 1); XLOAD(((t) + 1) * KVBLK); } \
        if ((t) <= lastj) { f32x16 p0, p1; float mn, al; bf16x8 pa0, pa1, pa2, pa3; \
            qkt<BUF, true>(p0, p1, lds, r32, hi, qr, qx); \
            if ((t) == lastj) mask_causal(p0, p1, qm - (t) * KVBLK); \
            partialSM(p0, p1, m_reg, mn, al); RESC(al); finishSM(p0, p1, al, l_reg, pa0, pa1, pa2, pa3); SBAR(); \
            pv_tile<BUF>(o, vb0, pa0, pa1, pa2, pa3); } \
        VM_WAIT(); if ((t) + 1 < je) XWRITE((BUF) ^ 1); \
        __syncthreads(); } while (0)
        for (int t = jb; t < je; t += 2) { STEP(t, 0); STEP(t + 1, 1); }
#undef STEP
#undef XLOAD
#undef XWRITE
    }
#undef RESC
#undef KDMA
#undef VDMA
#undef MLOAD
    if (part) {
        if (hi == 0) { pml[(wid * QBLK + r32) * 2] = m_reg; pml[(wid * QBLK + r32) * 2 + 1] = l_reg; }
#pragma unroll
        for (int r = 0; r < 16; ++r)
#pragma unroll
            for (int d0 = 0; d0 < 4; ++d0) part[(size_t)(wid * QBLK + crow(r, hi)) * D + d0 * 32 + r32] = o[d0][r];
        return;
    }
    if (hi == 0) li_l[r32] = l_reg; asm volatile("s_waitcnt lgkmcnt(0)" ::: "memory");
#pragma unroll
    for (int r = 0; r < 16; ++r) { const int orow = qlo + crow(r, hi); const float rl = __builtin_amdgcn_rcpf(li_l[crow(r, hi)]);
#pragma unroll
        for (int d0 = 0; d0 < 4; ++d0) { float v = o[d0][r] * rl; float vn = __shfl_xor(v, 1);
            if ((r32 & 1) == 0) { const int col = d0 * 32 + r32;
                if (MODE == 1) { const unsigned g = *(const unsigned*)(gate + (size_t)orow * 1024 + hoff + col); v *= bf_lo(g); vn *= bf_hi(g); }
                *(unsigned*)(Ob + (size_t)orow * DM + ocol0 + col) = cvt_pk_bf16(v, vn); } } }
}
#undef KSWZ
#undef SBAR
}

__device__ const unsigned short DSA_TAB[48] = {15, 287, 543, 286, 542, 14, 285, 541, 284, 540, 13, 283, 539, 282, 538, 12, 281, 537, 280, 536, 11, 279, 535, 278, 534, 10, 277, 533, 276, 532, 9, 275, 531, 274, 530, 8, 273, 529, 272, 528, 7, 6, 5, 4, 3, 2, 1, 0};

constexpr int MOE_NB_GU = 8 * 224 * 8, MOE_NB_DN = 8 * 32 * 28, MOE_NB = MOE_NB_GU + MOE_NB_DN;
__device__ __forceinline__ void moe_cvt_batch(const float* wg, const float* wu, const float* wd, unsigned char* ws, int b, int wave, int lane) {
    const float* sp; size_t ld; unsigned char* dp;
    if (b < MOE_NB_GU) { const int e = b / 1792, rr = b % 1792, nb = rr >> 3, kb = rr & 7, k0 = 256 * kb + 32 * wave, n0 = 64 * nb; const int tile = n0 >> 8, within = n0 & 255;
        sp = ((within < 128) ? wg : wu) + (size_t)e * DM * DFFE + (size_t)k0 * DFFE + tile * 128 + (within & 127) + lane; ld = DFFE;
        dp = (ws + WS_MWGU) + (size_t)e * 14336 * DM + (size_t)(n0 + lane) * DM + k0; }
    else { const int r = b - MOE_NB_GU; const int e = r / 896, rr = r % 896, nb = rr / 28, kb = rr % 28, k0 = 256 * kb + 32 * wave, n0 = 64 * nb;
        sp = wd + (size_t)e * DFFE * DM + (size_t)k0 * DM + n0 + lane; ld = DM; dp = (ws + WS_MWDN) + (size_t)e * DM * DFFE + (size_t)(n0 + lane) * DFFE + k0; }
    float v[32];
#pragma unroll
    for (int i = 0; i < 32; ++i) v[i] = __builtin_nontemporal_load(sp + (size_t)i * ld) * F8_WSCALE;
#pragma unroll
    for (int c = 0; c < 2; ++c) { u32x4 o; o.x = pk4_fp8(v[16 * c], v[16 * c + 1], v[16 * c + 2], v[16 * c + 3]); o.y = pk4_fp8(v[16 * c + 4], v[16 * c + 5], v[16 * c + 6], v[16 * c + 7]);
        o.z = pk4_fp8(v[16 * c + 8], v[16 * c + 9], v[16 * c + 10], v[16 * c + 11]); o.w = pk4_fp8(v[16 * c + 12], v[16 * c + 13], v[16 * c + 14], v[16 * c + 15]);
        *(u32x4*)(dp + 16 * c) = o; }
}
template <int NPULL>
__device__ __forceinline__ void xcd_barrier_fill(const XcdBarrier& b, volatile LAS unsigned* fs, unsigned* qctr, const float* wg, const float* wu, const float* wd, unsigned char* ws, int tid, int wave, int lane) {
    asm volatile("s_waitcnt vmcnt(0)" ::: "memory");
    __syncthreads();
    if (tid == 0) {
        unsigned* bar = b.bar;
        __builtin_amdgcn_s_waitcnt(0);
        unsigned nloc = b.st[0], nx = b.st[1];
        if (nloc == 0u) { xcd_barrier_complete(bar, b.x, nloc, nx); b.st[0] = nloc; b.st[1] = nx; }
        const unsigned old = xb_add(&bar[XB_XSUB(b.x)], 1u);
        const unsigned gen = old / nloc;
        if (old + 1u == (gen + 1u) * nloc) {
            __builtin_amdgcn_fence(__ATOMIC_RELEASE, "agent");
            asm volatile("s_waitcnt vmcnt(0)" ::: "memory");
            const unsigned og = xb_add(&bar[XB_TOP], 1u);
            const unsigned tg = og / nx;
            if (og + 1u == (tg + 1u) * nx) xb_add(&bar[XB_TOPGEN], 1u);
            else XB_SPIN(xb_ld(&bar[XB_TOPGEN]) == tg, bar);
            __builtin_amdgcn_fence(__ATOMIC_ACQUIRE, "agent");
            xb_add(&bar[XB_XGEN(b.x)], 1u);
            asm volatile("s_waitcnt vmcnt(0)" ::: "memory");
            fs[0] = 1u;
        } else { fs[0] = 0u; fs[1] = gen; }
    }
    __syncthreads();
    if (fs[0] == 0u) {
        const unsigned gen = fs[1];
        for (;;) {
            if (tid == 0) { const unsigned rel = (xb_ld(&b.bar[XB_XGEN(b.x)]) != gen) ? 1u : 0u; fs[2] = rel;
                fs[3] = rel ? 0u : __hip_atomic_fetch_add(qctr, (unsigned)NPULL, __ATOMIC_RELAXED, __HIP_MEMORY_SCOPE_AGENT); }
            __syncthreads();
            const unsigned rel = fs[2], bt = fs[3];
            if (rel) break;
            if (bt >= (unsigned)MOE_NB) {
                if (tid == 0) XB_SPIN(xb_ld(&b.bar[XB_XGEN(b.x)]) == gen, b.bar);
                break; }
#pragma unroll
            for (int q = 0; q < NPULL; ++q) if (bt + q < (unsigned)MOE_NB) moe_cvt_batch(wg, wu, wd, ws, (int)(bt + q), wave, lane);
            __syncthreads();
        }
        if (tid == 0) { __builtin_amdgcn_fence(__ATOMIC_ACQUIRE, "agent"); asm volatile("s_waitcnt vmcnt(0)" ::: "memory"); }
    }
    __syncthreads();
}

struct Args { const float* in[21]; float* out; unsigned char* ws; int ph_lo, ph_hi; };

struct Frame {
    LAS unsigned char* lds;
    int tid, lane, wave, vcu, G;
    unsigned char* ws;
};

__device__ __forceinline__ void tr_item(const float* srcp, size_t ldsrc, bf16_t* dst, size_t ldd, LAS float* scr, int lane) {
    const int c = lane & 31;
#pragma unroll 8
    for (int i = 0; i < 32; ++i) { const int kk = 2 * i + (lane >> 5); scr[kk * 33 + c] = srcp ? srcp[(size_t)kk * ldsrc] : 0.f; }
    LDS_WAIT();
    const int ch = lane & 7;
#pragma unroll
    for (int j = 0; j < 4; ++j) { const int n = (lane >> 3) + 8 * j; const LAS float* s = scr + (8 * ch) * 33 + n;
        u32x4 o; o.x = cvt_pk_bf16(s[0 * 33], s[1 * 33]); o.y = cvt_pk_bf16(s[2 * 33], s[3 * 33]); o.z = cvt_pk_bf16(s[4 * 33], s[5 * 33]); o.w = cvt_pk_bf16(s[6 * 33], s[7 * 33]);
        *(u32x4*)(dst + (size_t)n * ldd + 8 * ch) = o; }
    LDS_WAIT();
}
__device__ __forceinline__ int map_in(int n) {
    if (n < 4096) return n;
    if (n < 7168) return 4176 + (n - 4096);
    if (n < 8192) return 7256 + (n - 7168);
    if (n < 8256) return 4096 + (n - 8192);
    if (n < 8272) return 4160 + (n - 8256);
    if (n < 8280) return 7248 + (n - 8272);
    return -1;
}
__device__ __forceinline__ void rms_row_to_bf16(const float* xrow, const float* gain, bf16_t* orow, int lane) {
    const f32x4* xr = (const f32x4*)xrow + lane; const f32x4* gr = (const f32x4*)gain + lane;
    f32x4 v[8]; float s = 0.f;
#pragma unroll
    for (int j = 0; j < 8; ++j) { v[j] = xr[64 * j]; s += (v[j].x * v[j].x + v[j].y * v[j].y) + (v[j].z * v[j].z + v[j].w * v[j].w); }
    const float rstd = 1.f / sqrtf(wave_sum(s) * (1.f / DM) + RMS_EPS);
    u32x2* o8 = (u32x2*)orow + lane;
#pragma unroll
    for (int j = 0; j < 8; ++j) { const f32x4 g = gr[64 * j]; u32x2 w; w.x = cvt_pk_bf16(v[j].x * rstd * g.x, v[j].y * rstd * g.y); w.y = cvt_pk_bf16(v[j].z * rstd * g.z, v[j].w * rstd * g.w); o8[64 * j] = w; }
}

__global__ void __launch_bounds__(NTHREADS, 2) mega_fwd(Args args) {
    extern __shared__ __attribute__((aligned(16))) unsigned char lds_raw[];
    Frame F;
    F.lds = (LAS unsigned char*)lds_raw;
    F.tid = threadIdx.x; F.lane = F.tid & 63; F.wave = __builtin_amdgcn_readfirstlane(F.tid >> 6);
    F.G = gridDim.x; { const int bx = blockIdx.x; F.vcu = (F.G % 8 == 0) ? (bx % 8) * (F.G / 8) + bx / 8 : bx; }
    F.ws = args.ws;
    unsigned char* ws = args.ws;
    int tid = F.tid, lane = F.lane; const int wave = F.wave;
    const int gw = F.vcu * NWAVES + wave, NGW = F.G * NWAVES;
    volatile LAS unsigned* MISC = (volatile LAS unsigned*)(F.lds + MISC_OFF);
#if MK_FUSED
    for (int u = tid; u < (LDS_BYTES - RING_BYTES) / 4; u += NTHREADS) ((LAS unsigned*)(F.lds + RING_BYTES))[u] = 0u;
    __syncthreads();
    XcdBarrier bar = xcd_barrier_post((unsigned*)(ws + WS_CTL) + CW_BAR, MISC + 8);
    if (tid == 0) { MISC[20] = __hip_atomic_fetch_add((unsigned*)(ws + WS_CTL) + 3200 + 64 * (bar.x & 7u), 1u, __ATOMIC_RELAXED, __HIP_MEMORY_SCOPE_AGENT); MISC[21] = bar.x; }
#define GRID_BAR() xcd_barrier(bar)
#else
    (void)MISC;
#define GRID_BAR() do { } while (0)
#endif
    const int lo = args.ph_lo, hi = args.ph_hi;
    int gcid = (int)blockIdx.x;
#ifndef MK_PHASE_MASK
#define MK_PHASE_MASK 0x3ffff
#endif
#define IN(k) (((MK_PHASE_MASK >> (k)) & 1) && lo <= (k) && (k) < hi)
#define PHASE(k) if (IN(k))
#if MK_FUSED
#define SEAM(k) do { if (IN(k) && IN((k) + 1)) { if ((k) <= 14) xcd_barrier_fill<1>(bar, MISC + 12, (unsigned*)(ws + WS_CTL) + 3072, args.in[18], args.in[19], args.in[20], ws, tid, wave, lane); else xcd_barrier(bar); } } while (0)
#else
#define SEAM(k) do { } while (0)
#endif

#define WIN ((bf16_t*)(ws + WS_WIN))
#define WOUT ((bf16_t*)(ws + WS_WOUT))
#define WGU ((bf16_t*)(ws + WS_WGU))
#define WDN ((bf16_t*)(ws + WS_WDN))
#define WPOOL ((bf16_t*)(ws + WS_WPOOL))
#define MWGU8 ((unsigned char*)(ws + WS_MWGU))
#define MWDN8 ((unsigned char*)(ws + WS_MWDN))
#define SCORES ((float*)(ws + WS_BIG1))
#define ACT ((bf16_t*)(ws + WS_BIG1))
#define ACTM8 ((unsigned char*)(ws + WS_BIG1))
#define PROJ ((bf16_t*)(ws + WS_BIG2))
#define YM ((bf16_t*)(ws + WS_BIG2))
#define YMP ((float*)(ws + WS_YMP))
#define QA ((bf16_t*)(ws + WS_ATT))
#define KA (QA + (size_t)NH * S * HD)
#define VA (QA + (size_t)2 * NH * S * HD)
#define QB (QA + (size_t)3 * NH * S * HD)
#define KB (QA + (size_t)4 * NH * S * HD)
#define VB (QA + (size_t)5 * NH * S * HD)
#define GBG (QA + (size_t)6 * NH * S * HD)
#define QI (GBG + (size_t)S * 1024)
#define HS8 ((unsigned char*)(ws + WS_ATT))
#define MASK ((unsigned long long*)(ws + WS_MASK))
#define OB ((bf16_t*)(ws + WS_O))
#define POOLED ((bf16_t*)(ws + WS_O))
#define HB ((bf16_t*)(ws + WS_H))
#define X1 ((float*)(ws + WS_X1))
#define X3 ((float*)(ws + WS_X1))
#define X2 ((float*)(ws + WS_X2))
#define WI ((float*)(ws + WS_WI))
#define LOGF ((float*)(ws + WS_LOGF))
#define CC ((float*)(ws + WS_CC))
#define TOKE ((unsigned*)(ws + WS_TOKE))
#define TOKG ((f32x2*)(ws + WS_TOKG))
#define RSTD3 ((float*)(ws + WS_RSTD3))
#define SLOT ((u32x2*)(ws + WS_SLOT))
#define CNT ((unsigned*)(ws + WS_CNT))
#define TEXP ((int*)(ws + WS_TEXP))
#define KI ((bf16_t*)(ws + WS_KI))
#define QX ((bf16_t*)(ws + WS_QX))
#define NQB ((float*)(ws + WS_NQB))
#define NKB ((float*)(ws + WS_NKB))
#define JLO ((int*)(ws + WS_JLO))
#define ROT ((float*)(ws + WS_ROT))
#define QLIN ((bf16_t*)(ws + WS_QLIN))
#define PART ((float*)(ws + WS_PART))
#define PML ((float*)(ws + WS_PART + 32 * MiB))
#define KX ((bf16_t*)(ws + WS_KX))
#define x_in (args.in[0])

    PHASE(0) {
        LAS unsigned char* tscr = F.lds + wave * 8192;
        constexpr int I_IN = 132 * 32, I_OUT = 32 * 32, I_GU = 176 * 32, I_DN = 32 * 88, I_PL = 4 * 8 * 8;
        constexpr int NITEMS = I_IN + I_OUT + I_GU + I_DN + I_PL;
        for (int it = gw; it < NITEMS; it += NGW) {
            int r = it; const float* sp; size_t ld, dpitch; bf16_t* dp0;
            if (r < I_IN) { const int kb = r / 132, nb = r % 132, k0 = 64 * kb, n0 = 64 * nb; const int scn = map_in(n0 + lane);
                sp = scn >= 0 ? args.in[2] + (size_t)k0 * 8280 + scn : nullptr; ld = 8280; dp0 = WIN + (size_t)n0 * DM + k0; dpitch = DM * 2; }
            else if ((r -= I_IN) < I_OUT) { const int kb = r / 32, nb = r % 32, k0 = 64 * kb, n0 = 64 * nb;
                sp = args.in[8] + (size_t)k0 * DM + n0 + lane; ld = DM; dp0 = WOUT + (size_t)n0 * DM + k0; dpitch = DM * 2; }
            else if ((r -= I_OUT) < I_GU) { const int kb = r / 176, nb = r % 176, k0 = 64 * kb, n0 = 64 * nb; const int tile = n0 >> 8, within = n0 & 255;
                sp = ((within < 128) ? args.in[10] : args.in[11]) + (size_t)k0 * DFF + tile * 128 + (within & 127) + lane; ld = DFF; dp0 = WGU + (size_t)n0 * DM + k0; dpitch = DM * 2; }
            else if ((r -= I_GU) < I_DN) { const int kb = r / 32, nb = r % 32, k0 = 64 * kb, n0 = 64 * nb;
                sp = args.in[12] + (size_t)k0 * DM + n0 + lane; ld = DM; dp0 = WDN + (size_t)n0 * DFF + k0; dpitch = DFF * 2; }
            else { r -= I_DN; const int g = r / 64, rr = r % 64, kb = rr / 8, nb = rr % 8, k0 = 64 * kb, n0 = 64 * nb;
                sp = args.in[14] + (size_t)g * 512 * 512 + (size_t)k0 * 512 + n0 + lane; ld = 512; dp0 = WPOOL + (size_t)g * 512 * 512 + (size_t)n0 * 512 + k0; dpitch = 512 * 2; }
            float v[64];
#pragma unroll
            for (int i = 0; i < 64; ++i) v[i] = sp ? __builtin_nontemporal_load(sp + (size_t)i * ld) : 0.f;
#pragma unroll
            for (int c8 = 0; c8 < 8; ++c8) { u32x4 o; o.x = cvt_pk_bf16(v[8 * c8], v[8 * c8 + 1]); o.y = cvt_pk_bf16(v[8 * c8 + 2], v[8 * c8 + 3]); o.z = cvt_pk_bf16(v[8 * c8 + 4], v[8 * c8 + 5]); o.w = cvt_pk_bf16(v[8 * c8 + 6], v[8 * c8 + 7]);
                *(LAS u32x4*)(tscr + lane * 128 + ((c8 ^ (lane & 7)) << 4)) = o; }
            LDS_WAIT();
#pragma unroll
            for (int i = 0; i < 8; ++i) { const int row = 8 * i + (lane >> 3), ch = lane & 7;
                *(u32x4*)((char*)dp0 + (size_t)row * dpitch + ch * 16) = *(const LAS u32x4*)(tscr + row * 128 + ((ch ^ (row & 7)) << 4)); }
            LDS_WAIT();
        }
        for (int e_ = gw * 64 + lane; e_ < S * 16; e_ += NGW * 64) {
            const int m = e_ >> 4, i = e_ & 15; const float fm = powf(500000.0f, -(float)i * (1.0f / 16.0f)), am = (float)m * fm; *(f32x2*)(ROT + (size_t)e_ * 2) = (f32x2){cosf(am), sinf(am)}; }
        for (int m = gw; m < S; m += NGW) rms_row_to_bf16(x_in + (size_t)m * DM, args.in[1], HB + (size_t)m * DM, lane);
    }
    SEAM(0);
#if MK_FUSED
    if (IN(0) && IN(1)) {
        if (tid == 0) { unsigned* bw = (unsigned*)(ws + WS_CTL) + CW_BAR; bool ok = (F.G % 8) == 0 && MISC[21] < 8u;
            for (int j = 0; j < 8; ++j) ok = ok && (xb_ld(&bw[XB_XCNT(j)]) == (unsigned)(F.G / 8));
            MISC[22] = ok ? (MISC[20] * 8u + MISC[21]) : (unsigned)blockIdx.x; }
        __syncthreads();
        gcid = __builtin_amdgcn_readfirstlane((int)MISC[22]);
    }
#endif

    PHASE(1) {
        pg8::SchedPlain Sd{(const char*)HB, (const char*)WIN, S / 256, NINP / 256, F.G, gcid, (size_t)256 * DM * 2};
        pg8::EpiInProj E{PROJ, NINP, VA, VB, GBG};
        pg8::gemm_phase(F.lds, DM * 2, DM * 2 / 128, Sd, E);
    }
    SEAM(1);

    PHASE(2) {
        const float* qn_a = args.in[4]; const float* kn_a = args.in[5]; const float* qn_b = args.in[6]; const float* kn_b = args.in[7]; const float* bfor = args.in[3];
        const float ga0 = qn_a[2 * lane], ga1 = qn_a[2 * lane + 1], gk0 = kn_a[2 * lane], gk1 = kn_a[2 * lane + 1];
        const float gb0 = qn_b[2 * lane], gb1 = qn_b[2 * lane + 1], gkb0 = kn_b[2 * lane], gkb1 = kn_b[2 * lane + 1];
        const int TPW = S / NGW;
        unsigned nx[25]; bf16_t nwi, nfb;
#define P2_LOAD(tt) do { const unsigned* pr_ = (const unsigned*)(PROJ + (size_t)(tt) * NINP) + lane; \
            _Pragma("unroll") for (int j_ = 0; j_ < 8; ++j_) { nx[j_] = pr_[64 * (8 + j_)]; nx[8 + j_] = pr_[64 * (24 + j_)]; nx[16 + j_] = pr_[64 * (40 + j_)]; } \
            nx[24] = pr_[64 * 64]; nwi = PROJ[(size_t)(tt) * NINP + C_WI + (lane & 15)]; nfb = PROJ[(size_t)(tt) * NINP + C_FB + (lane & 7)]; } while (0)
        const int t0_ = gw * TPW;
        P2_LOAD(t0_);
        for (int t = t0_; t < t0_ + TPW; ++t) {
            unsigned pv[65];
#pragma unroll
            for (int j = 0; j < 8; ++j) { pv[8 + j] = nx[j]; pv[24 + j] = nx[8 + j]; pv[40 + j] = nx[16 + j]; }
            pv[64] = nx[24]; const bf16_t wi_raw = nwi, fb_raw = nfb;
            const int i0 = 2 * (lane & 7), j0 = 2 * (lane & 3);
            const f32x4 cm = *(const f32x4*)(ROT + ((size_t)t * 16 + i0) * 2);
            const f32x2 ci0 = *(const f32x2*)(ROT + ((size_t)t * 16 + 2 * j0) * 2), ci1 = *(const f32x2*)(ROT + ((size_t)t * 16 + 2 * j0 + 2) * 2);
            const float c0 = cm[0], s0 = cm[1], c1 = cm[2], s1 = cm[3], ic0 = ci0[0], is0 = ci0[1], ic1 = ci1[0], is1 = ci1[1];
            if (t + 1 < t0_ + TPW) P2_LOAD(t + 1);
            const float wsc = bf1(wi_raw) * (1.0f / 32.0f); float qla = 0.f, qlb = 0.f;
#pragma unroll
            for (int h = 0; h < NH; ++h) {
#pragma unroll
                for (int which = 1; which < 2; ++which) {
                    const unsigned w = pv[(which ? 8 : 0) + h];
                    float a = bf_lo(w), b = bf_hi(w);
                    const float r = 1.f / sqrtf(wave_sum(a * a + b * b) * (1.f / HD) + RMS_EPS);
                    a *= r * (which ? gk0 : ga0); b *= r * (which ? gk1 : ga1);
                    const float pa = __shfl_xor(a, 8), pb = __shfl_xor(b, 8);
                    if (lane < 8) { a = a * c0 - pa * s0; b = b * c1 - pb * s1; }
                    else if (lane < 16) { a = a * c0 + pa * s0; b = b * c1 + pb * s1; }
                    ((unsigned*)((which ? KA : QA) + ((size_t)h * S + t) * HD))[lane] = cvt_pk_bf16(a, b);
                }
#pragma unroll
                for (int which = 1; which < 2; ++which) {
                    const unsigned w = pv[(which ? 40 : 32) + h];
                    float a = bf_lo(w), b = bf_hi(w);
                    const float r = 1.f / sqrtf(wave_sum(a * a + b * b) * (1.f / HD) + RMS_EPS);
                    a *= r * (which ? gkb0 : gb0); b *= r * (which ? gkb1 : gb1);
                    { const float n2 = wave_sum(a * a + b * b); if (lane == 0) (which ? NKB : NQB)[(size_t)h * S + t] = n2; }
                    ((unsigned*)((which ? KB : QB) + ((size_t)h * S + t) * HD))[lane] = cvt_pk_bf16(a, b);
                }
                { const unsigned w = pv[24 + h]; float a = bf_lo(w), b = bf_hi(w);
                  const float pa = __shfl_xor(a, 4), pb = __shfl_xor(b, 4); const int l5 = lane & 31;
                  if (l5 < 4) { a = a * ic0 - pa * is0; b = b * ic1 - pb * is1; }
                  else if (l5 < 8) { a = a * ic0 + pa * is0; b = b * ic1 + pb * is1; }
                  const unsigned pk = cvt_pk_bf16(a, b); ((unsigned*)(QI + (size_t)t * 1024 + h * HD))[lane] = pk;
                  const float wv = __shfl(wsc, 2 * h + (lane >> 5)); qla = fmaf(wv, bf_lo(pk), qla); qlb = fmaf(wv, bf_hi(pk), qlb); }
            }
            { const float ta = qla + __shfl_xor(qla, 32), tb = qlb + __shfl_xor(qlb, 32);
              if (lane < 32) ((unsigned*)(QLIN + (size_t)t * IDD))[lane] = cvt_pk_bf16(ta, tb); }
            { const unsigned w = pv[64]; float a = bf_lo(w), b = bf_hi(w);
              const float pa = __shfl_xor(a, 4), pb = __shfl_xor(b, 4); const int l5 = lane & 31;
              if (l5 < 4) { a = a * ic0 - pa * is0; b = b * ic1 - pb * is1; }
              else if (l5 < 8) { a = a * ic0 + pa * is0; b = b * ic1 + pb * is1; }
              if (lane < 32) ((unsigned*)(KI + (size_t)t * IDD))[lane] = cvt_pk_bf16(a, b); }
            if (lane < 16) WI[(size_t)t * 16 + lane] = wsc;
            if (lane < 8) { const float z = bf1(fb_raw) + bfor[lane]; LOGF[(size_t)lane * S + t] = fminf(z, 0.f) - log1pf(__expf(-fabsf(z))); }
        }
    }
#undef P2_LOAD
    SEAM(2);

    PHASE(3) {
        if ((int)blockIdx.x >= F.G - NH) {
            const int h = (int)blockIdx.x - (F.G - NH); LAS double* sd = (LAS double*)F.lds;
            double loc[16]; double s = 0.0;
#pragma unroll
            for (int i = 0; i < 16; ++i) { s += (double)LOGF[(size_t)h * S + tid * 16 + i]; loc[i] = s; }
            sd[tid] = s; __syncthreads();
            if (tid == 0) { double run = 0.0; for (int i = 0; i < NTHREADS; ++i) { const double v = sd[i]; sd[i] = run; run += v; } }
            __syncthreads();
            const double base = sd[tid];
#pragma unroll
            for (int i = 0; i < 16; ++i) CC[(size_t)h * S + tid * 16 + i] = (float)(base + loc[i]);
            LAS float* cend = (LAS float*)(F.lds + 8192); LAS float* cp0 = cend + 128; LAS float* redm = cp0 + 32;
            { float mq = 0.f, mk = 0.f;
              { const float* gq = args.in[6]; for (int i = 0; i < HD; ++i) mq = fmaxf(mq, gq[i] * gq[i]); mq *= (float)HD; }
#pragma unroll
              for (int i = 0; i < 16; ++i) { const int e_ = tid * 16 + i; mk = fmaxf(mk, NKB[(size_t)h * S + e_]);
                  const float cv = (float)(base + loc[i]); if ((e_ & 63) == 63) cend[e_ >> 6] = cv; if ((e_ & 255) == 0) cp0[e_ >> 8] = cv; }
#pragma unroll
              for (int o = 1; o < 64; o <<= 1) { mq = fmaxf(mq, __shfl_xor(mq, o)); mk = fmaxf(mk, __shfl_xor(mk, o)); }
              if (lane == 0) { redm[wave] = mq; redm[8 + wave] = mk; } }
            __syncthreads();
            if (tid < 32) { float mq = redm[0], mk = redm[8];
#pragma unroll
                for (int i = 1; i < NWAVES; ++i) { mq = fmaxf(mq, redm[i]); mk = fmaxf(mk, redm[8 + i]); }
                const float T = 2.f * (ATT_SCALE * sqrtf(mq * mk) * 1.02f) + 27.f, c0 = cp0[tid];
                int j = 0; while (j < 4 * tid && c0 - cend[j] < -T) ++j;
                JLO[h * 32 + tid] = j & ~1; }
#pragma unroll
            for (int i = 0; i < 16; ++i) { const double cs = (base + loc[i]) * 11.313708498984761;
                const unsigned b1 = cvt_pk_bf16((float)cs, 0.f) & 0xffffu; const double r1 = cs - (double)__uint_as_float(b1 << 16);
                const unsigned b2 = cvt_pk_bf16((float)r1, 0.f) & 0xffffu; const double r2 = r1 - (double)__uint_as_float(b2 << 16);
                const unsigned b3 = cvt_pk_bf16((float)r2, 0.f) & 0xffffu; const unsigned one = 0x3f80u;
                const size_t e = ((size_t)h * S + tid * 16 + i) * 8;
                *(u32x4*)(QX + e) = (u32x4){b1 | (b2 << 16), b3 | (one << 16), one | (one << 16), 0u};
                *(u32x4*)(KX + e) = (u32x4){one | (one << 16), one | ((b1 ^ 0x8000u) << 16), (b2 ^ 0x8000u) | ((b3 ^ 0x8000u) << 16), 0u}; }
            __syncthreads();
        }
        const int r32 = lane & 31, hi5 = lane >> 5;
        constexpr int NITEM = 1152;
#define IDX_DECODE(it_, q0_, seg_, nadm_) do { int g_ = 0; while (32 * (g_ + 1) * (g_ + 2) / 2 <= (it_)) ++g_; \
            const int rem_ = (it_) - 32 * g_ * (g_ + 1) / 2, nseg_ = g_ + 1; q0_ = (g_ * 32 + rem_ / nseg_) * 32; seg_ = rem_ % nseg_; nadm_ = (q0_ / 64 + 1) * 64; } while (0)
#define IDX_STAGE_Q(b_, q0_) do { const bf16_t* qsrc_ = QI + (size_t)(q0_) * 1024; _Pragma("unroll") for (int i_ = 0; i_ < 8; ++i_) \
            pg8::glds16_s((const void*)qsrc_, (unsigned)((lane & 31) * 2048 + (2 * wave + 16 * i_ + (lane >> 5)) * 16), ldsb3 + (unsigned)(b_) * 65536u + (unsigned)(2 * wave + 16 * i_) * 512u); } while (0)
        const unsigned ldsb3 = (unsigned)(uintptr_t)F.lds;
        LAS float* const Wsb = (LAS float*)(F.lds + RING_BYTES + 1024);
        int it = blockIdx.x, buf = 0, q0 = 0, seg = 0, nadm = 0;
        __syncthreads();
        if (it < NITEM) { IDX_DECODE(it, q0, seg, nadm); IDX_STAGE_Q(0, q0); Wsb[(tid >> 5) * 32 + (tid & 31)] = WI[(size_t)(q0 + (tid & 31)) * 16 + (tid >> 5)]; }
        for (; it < NITEM; it += F.G) {
            const int kb0 = seg * 1024 + wave * 128; const bool act = kb0 < nadm;
            bf16x8 kf[4][4], qlf[4];
            if (act) {
#pragma unroll
                for (int j = 0; j < 4; ++j)
#pragma unroll
                    for (int ks = 0; ks < 4; ++ks) kf[j][ks] = *(const bf16x8*)(KI + (size_t)(kb0 + 32 * j + r32) * IDD + ks * 16 + hi5 * 8);
#pragma unroll
                for (int ks = 0; ks < 4; ++ks) qlf[ks] = *(const bf16x8*)(QLIN + (size_t)(q0 + r32) * IDD + ks * 16 + hi5 * 8);
            }
            VM_WAIT();
            __syncthreads();
            const int nit = it + F.G; const bool has_next = nit < NITEM; int nq0 = 0, nseg2 = 0, nnadm = 0; float wn = 0.f;
            if (has_next) { IDX_DECODE(nit, nq0, nseg2, nnadm); IDX_STAGE_Q(buf ^ 1, nq0); wn = WI[(size_t)(nq0 + (tid & 31)) * 16 + (tid >> 5)]; }
            if (act) {
                LAS unsigned char* Qs = F.lds + buf * 65536; LAS float* Ws = Wsb + buf * 512;
                f32x16 sacc[4];
#pragma unroll
                for (int j = 0; j < 4; ++j) sacc[j] = f32x16{};
#pragma unroll 2
                for (int h = 0; h < NIH; ++h) {
                    bf16x8 qf[4];
#pragma unroll
                    for (int ks = 0; ks < 4; ++ks) qf[ks] = *(const LAS bf16x8*)(Qs + (((h * 4 + ks) * 2 + hi5) * 32 + r32) * 16);
                    const float wh = Ws[h * 32 + r32];
#pragma unroll
                    for (int j = 0; j < 4; ++j) { f32x16 c = f32x16{};
#pragma unroll
                        for (int ks = 0; ks < 4; ++ks) c = __builtin_amdgcn_mfma_f32_32x32x16_bf16(kf[j][ks], qf[ks], c, 0, 0, 0);
#pragma unroll
                        for (int r = 0; r < 16; ++r) sacc[j][r] = fmaf(wh, __builtin_fabsf(c[r]), sacc[j][r]); }
                }
#pragma unroll
                for (int j = 0; j < 4; ++j) { f32x16 c = f32x16{};
#pragma unroll
                    for (int ks = 0; ks < 4; ++ks) c = __builtin_amdgcn_mfma_f32_32x32x16_bf16(kf[j][ks], qlf[ks], c, 0, 0, 0);
#pragma unroll
                    for (int r = 0; r < 16; ++r) sacc[j][r] = 0.5f * (sacc[j][r] + c[r]); }
                float* srow = SCORES + (size_t)(q0 + r32) * S;
#pragma unroll
                for (int j = 0; j < 4; ++j) if (kb0 + 32 * j < nadm) {
#pragma unroll
                    for (int rg = 0; rg < 4; ++rg) *(f32x4*)(srow + kb0 + 32 * j + 8 * rg + 4 * hi5) = (f32x4){sacc[j][4 * rg], sacc[j][4 * rg + 1], sacc[j][4 * rg + 2], sacc[j][4 * rg + 3]}; }
            }
            if (has_next) { Wsb[(buf ^ 1) * 512 + (tid >> 5) * 32 + (tid & 31)] = wn; q0 = nq0; seg = nseg2; nadm = nnadm; buf ^= 1; }
        }
        VM_WAIT(); __syncthreads();
#undef IDX_DECODE
#undef IDX_STAGE_Q
    }
    SEAM(3);

    PHASE(4) {
        constexpr int P4_CAP = 24, P4_WAVE_BYTES = 8448 + (P4_CAP + 1) * 256;
        LAS unsigned* hist = (LAS unsigned*)(F.lds + wave * P4_WAVE_BYTES);
        LAS unsigned* clist = hist + 2112;
        auto scan_hist = [&](unsigned kk, unsigned& bin_o, unsigned& cab_o, unsigned& cbin_o) __attribute__((always_inline)) {
            unsigned c32 = 0u;
#pragma unroll
            for (int j = 0; j < 32; ++j) c32 += hist[33 * lane + j];
            unsigned incl = c32;
#pragma unroll
            for (int o = 1; o < 64; o <<= 1) { const unsigned v = __shfl_down(incl, o); if (lane + o < 64) incl += v; }
            const unsigned above = incl - c32;
            const unsigned long long bal = __ballot((above < kk) && (kk <= incl));
            const int srcl = bal ? (int)__ffsll((long long)bal) - 1 : 0;
            const unsigned a0 = __shfl(above, srcl);
            const unsigned hj = (lane < 32) ? hist[33 * srcl + lane] : 0u;
            unsigned si = hj;
#pragma unroll
            for (int o = 1; o < 32; o <<= 1) { const unsigned v = __shfl_down(si, o); if (lane + o < 64) si += v; }
            const unsigned ab2 = a0 + si - hj;
            const unsigned long long bal2 = __ballot((lane < 32) && (ab2 < kk) && (kk <= ab2 + hj));
            const int j2 = bal2 ? (int)__ffsll((long long)bal2) - 1 : 0;
            bin_o = 32u * (unsigned)srcl + (unsigned)j2; cab_o = __shfl(ab2, j2); cbin_o = __shfl(hj, j2);
        };
        auto zero_hist = [&]() __attribute__((always_inline)) {
#pragma unroll
            for (int q = 0; q < 9; ++q) if (lane + 64 * q < 528) ((LAS u32x4*)hist)[lane + 64 * q] = (u32x4){0u, 0u, 0u, 0u};
            LDS_WAIT();
        };
        for (int t = gw; t < S; t += NGW) {
            const int n = (t / 64 + 1) * 64, nw = n / 64;
            unsigned long long w0 = 0ull, w1 = 0ull;
            if (n <= TOPK) { w0 = (lane < nw) ? ~0ull : 0ull; }
            else {
                const float* srow = SCORES + (size_t)t * S + lane;
                unsigned key[128];
#pragma unroll
                for (int i = 0; i < 128; ++i) key[i] = __float_as_uint(srow[64 * ((i < nw) ? i : 0)]);
#pragma unroll
                for (int i = 0; i < 128; ++i) { const unsigned u = key[i]; key[i] = (i < nw) ? ((u & 0x80000000u) ? ~u : (u | 0x80000000u)) : 0u; }
                unsigned prefix, kk = TOPK, bin, cab, cbin;
                zero_hist();
#pragma unroll
                for (int c = 0; c < 8; ++c) {
                    if (16 * c < nw) {
#pragma unroll
                        for (int j = 0; j < 16; ++j) { const unsigned d = key[16 * c + j] >> 21;
                            __hip_atomic_fetch_add(hist + (d + (d >> 5)), 1u, __ATOMIC_RELAXED, __HIP_MEMORY_SCOPE_WORKGROUP); }
                    }
                }
                LDS_WAIT();
                scan_hist(kk, bin, cab, cbin);
                kk -= cab; prefix = bin << 21;
                LDS_WAIT();
                unsigned cnt = 0u;
#pragma unroll
                for (int c = 0; c < 8; ++c) {
                    if (16 * c < nw) {
#pragma unroll
                        for (int j = 0; j < 16; ++j) { const unsigned k_ = key[16 * c + j];
                            clist[(cnt < (unsigned)P4_CAP ? cnt : (unsigned)P4_CAP) * 64u + lane] = k_;
                            cnt += ((k_ >> 21) == bin) ? 1u : 0u; }
                    }
                }
                unsigned mx = cnt;
#pragma unroll
                for (int o = 32; o > 0; o >>= 1) { const unsigned v = __shfl_xor(mx, o); mx = (v > mx) ? v : mx; }
                const int maxc = __builtin_amdgcn_readfirstlane((int)mx);
                LDS_WAIT();
#pragma unroll 1
                for (int pass = 1; pass < 3; ++pass) {
                    const int shift = (pass == 1) ? 10 : 0;
                    const unsigned dmask = (pass == 2) ? 1023u : 2047u;
                    const unsigned pmask = (pass == 1) ? 0xffe00000u : 0xfffffc00u;
                    zero_hist();
                    if (maxc <= P4_CAP) {
#pragma unroll 1
                        for (int s = 0; s < maxc; ++s) {
                            if ((unsigned)s < cnt) { const unsigned k_ = clist[s * 64 + lane];
                                if (((k_ ^ prefix) & pmask) == 0u) { const unsigned d = (k_ >> shift) & dmask;
                                    __hip_atomic_fetch_add(hist + (d + (d >> 5)), 1u, __ATOMIC_RELAXED, __HIP_MEMORY_SCOPE_WORKGROUP); } }
                        }
                    } else {
#pragma unroll
                        for (int c = 0; c < 8; ++c) {
                            if (16 * c < nw) {
#pragma unroll
                                for (int j = 0; j < 16; ++j) { const unsigned k_ = key[16 * c + j];
                                    if (((k_ ^ prefix) & pmask) == 0u) { const unsigned d = (k_ >> shift) & dmask;
                                        __hip_atomic_fetch_add(hist + (d + (d >> 5)), 1u, __ATOMIC_RELAXED, __HIP_MEMORY_SCOPE_WORKGROUP); } }
                            }
                        }
                    }
                    LDS_WAIT();
                    scan_hist(kk, bin, cab, cbin);
                    kk -= cab; prefix |= bin << shift;
                    LDS_WAIT();
                    if (kk == cbin) break;
                }
                int w0l = 0, w0h = 0, w1l = 0, w1h = 0;
#pragma unroll
                for (int i = 0; i < 64; ++i) { const unsigned long long b0 = __ballot(key[i] >= prefix), b1 = __ballot(key[64 + i] >= prefix);
                    w0l = wl_i32((int)(unsigned)b0, i, w0l); w0h = wl_i32((int)(unsigned)(b0 >> 32), i, w0h);
                    w1l = wl_i32((int)(unsigned)b1, i, w1l); w1h = wl_i32((int)(unsigned)(b1 >> 32), i, w1h); }
                w0 = ((unsigned long long)(unsigned)w0h << 32) | (unsigned)w0l; w1 = ((unsigned long long)(unsigned)w1h << 32) | (unsigned)w1l;
            }
            MASK[(size_t)t * 128 + lane] = w0; MASK[(size_t)t * 128 + 64 + lane] = w1;
        }
    }
    SEAM(4);

    PHASE(5) {
        LAS unsigned* qsl = (LAS unsigned*)(F.lds + fa::OFF_W + NWAVES * 64 * 4);
        unsigned* const qctr = (unsigned*)(ws + WS_CTL) + 2048;
        const int myx = (int)(xb_xcc_id() & 7u);
        if (MK_ATT_MODES & 1) for (int qi = 0; qi < NH; ++qi) { const int h = (myx + qi) & 7; const size_t ho = (size_t)h * S * HD;
            for (;;) {
                __syncthreads();
                { int l0; asm volatile("v_mbcnt_lo_u32_b32 %0, -1, 0\n\tv_mbcnt_hi_u32_b32 %0, -1, %0" : "=v"(l0)); if (wave == 0 && l0 == 0) qsl[0] = __hip_atomic_fetch_add(qctr + 64 * h, 1u, __ATOMIC_RELAXED, __HIP_MEMORY_SCOPE_AGENT); }
                __syncthreads();
                const unsigned idx = qsl[0]; if (idx >= 48u) break;
                const int ent = DSA_TAB[idx], qb = ent & 255, prt = ent >> 8, NTq = 4 * (qb + 1);
                const int jb = (prt == 2) ? NTq / 2 : 0, je = (prt == 1) ? NTq / 2 : NTq;
                const int slot = (h * 16 + (qb - 16)) * 2 + (prt - 1);
                fa::attn_block<0>((char*)lds_raw, PROJ + C_QA + h * HD, args.in[4], ROT, KA + ho, VA + ho, nullptr, nullptr, MASK, nullptr, OB, h * HD, 0, qb * 256, jb, je,
                                  prt ? PART + (size_t)slot * 256 * HD : nullptr, prt ? PML + (size_t)slot * 512 : nullptr);
            } }
        if (MK_ATT_MODES & 2) for (int qi = 0; qi < NH; ++qi) { const int h = (myx + qi) & 7; const size_t ho = (size_t)h * S * HD;
            for (;;) {
                __syncthreads();
                { int l0; asm volatile("v_mbcnt_lo_u32_b32 %0, -1, 0\n\tv_mbcnt_hi_u32_b32 %0, -1, %0" : "=v"(l0)); if (wave == 0 && l0 == 0) qsl[0] = __hip_atomic_fetch_add(qctr + 512 + 64 * h, 1u, __ATOMIC_RELAXED, __HIP_MEMORY_SCOPE_AGENT); }
                __syncthreads();
                const unsigned idx = qsl[0]; if (idx >= 32u) break;
                const int qb = 31 - (int)idx;
                const int jb = __builtin_amdgcn_readfirstlane(JLO[h * 32 + qb]);
                fa::attn_block<1>((char*)lds_raw, PROJ + C_QB + h * HD, args.in[6], nullptr, KB + ho, VB + ho, QX + (size_t)h * S * 8, KX + (size_t)h * S * 8, nullptr, GBG, OB, 1024 + h * HD, h * HD, qb * 256, jb, 4 * (qb + 1), nullptr, nullptr);
            } }
        __syncthreads();
    }
    { int l2; asm volatile("v_mbcnt_lo_u32_b32 %0, -1, 0\n\tv_mbcnt_hi_u32_b32 %0, -1, %0" : "=v"(l2)); lane = l2; tid = wave * 64 + l2; }
    SEAM(5);

    PHASE(6) {
        for (int u = F.vcu; u < 256; u += F.G) {
            const int blk = u >> 1, h = blk >> 4, qb = 16 + (blk & 15), row = (u & 1) * 128 + (tid >> 2), cq = (tid & 3) * 32;
            const float* p1 = PART + (size_t)(blk * 2) * 256 * HD + (size_t)row * HD + cq; const float* p2 = p1 + (size_t)256 * HD;
            const float* ml1 = PML + (size_t)(blk * 2) * 512 + row * 2; const float* ml2 = ml1 + 512;
            const float m1 = ml1[0], l1 = ml1[1], m2 = ml2[0], l2 = ml2[1], m = fmaxf(m1, m2);
            constexpr float C2 = 1.4426950408889634f * ATT_SCALE;
            const float a1 = __builtin_amdgcn_exp2f((m1 - m) * C2), a2 = __builtin_amdgcn_exp2f((m2 - m) * C2), rl = 1.f / (l1 * a1 + l2 * a2), w1 = a1 * rl, w2 = a2 * rl;
            bf16_t* op = OB + (size_t)(qb * 256 + row) * DM + h * HD + cq;
#pragma unroll
            for (int c = 0; c < 4; ++c) { const f32x4 x0 = *(const f32x4*)(p1 + 8 * c) * w1 + *(const f32x4*)(p2 + 8 * c) * w2, x1 = *(const f32x4*)(p1 + 8 * c + 4) * w1 + *(const f32x4*)(p2 + 8 * c + 4) * w2;
                u32x4 w; w.x = cvt_pk_bf16(x0[0], x0[1]); w.y = cvt_pk_bf16(x0[2], x0[3]); w.z = cvt_pk_bf16(x1[0], x1[1]); w.w = cvt_pk_bf16(x1[2], x1[3]);
                *(u32x4*)(op + 8 * c) = w; }
        }
    }
    SEAM(6);

    PHASE(7) {
        pg8::SchedPlain Sd{(const char*)OB, (const char*)WOUT, S / 256, DM / 256, F.G, gcid, (size_t)256 * DM * 2};
        pg8::EpiResid E{x_in, X1, DM, nullptr, 1.f};
        pg8::gemm_phase(F.lds, DM * 2, DM * 2 / 128, Sd, E);
    }
    SEAM(7);

    PHASE(8) { for (int m = gw; m < S; m += NGW) rms_row_to_bf16(X1 + (size_t)m * DM, args.in[9], HB + (size_t)m * DM, lane); }
    SEAM(8);

    PHASE(9) {
        pg8::SchedPlain Sd{(const char*)HB, (const char*)WGU, S / 256, 2 * DFF / 256, F.G, gcid, (size_t)256 * DM * 2};
        pg8::EpiSwiglu E{ACT, DFF};
        pg8::gemm_phase(F.lds, DM * 2, DM * 2 / 128, Sd, E);
    }
    SEAM(9);

    PHASE(10) {
        pg8::SchedPlain Sd{(const char*)ACT, (const char*)WDN, S / 256, DM / 256, F.G, gcid, (size_t)256 * DFF * 2};
        pg8::EpiResid E{X1, X2, DM, nullptr, 1.f};
        pg8::gemm_phase(F.lds, DFF * 2, DFF * 2 / 128, Sd, E);
    }
    SEAM(10);

    PHASE(11) {
        LAS float* part = (LAS float*)F.lds;
        LAS float* rs = part + 47 * NWAVES;
        const int RB = S / F.G, r0 = F.vcu * RB;
        const int c4 = tid * 4, grp = wave >> 1;
        const f32x4 g4 = *(const f32x4*)(args.in[13] + c4);
        const float* xc = X2 + c4;
        for (int rb = r0; rb < r0 + RB; rb += 32) {
            f32x4 v[32], h[15];
#pragma unroll
            for (int i = 0; i < 32; ++i) v[i] = *(const f32x4*)(xc + (size_t)(rb + i) * DM);
#pragma unroll
            for (int j = 0; j < 15; ++j) { const int row = rb - 1 - j; h[j] = *(const f32x4*)(xc + (size_t)((row >= 0) ? row : rb) * DM) * ((row >= 0) ? 1.f : 0.f); }
#pragma unroll
            for (int k = 0; k < 47; ++k) { const f32x4 x = (k < 15) ? h[(k < 15) ? 14 - k : 0] : v[(k >= 15) ? k - 15 : 0];
                const float s = wave_sum((x.x * x.x + x.y * x.y) + (x.z * x.z + x.w * x.w)); if (lane == 0) part[k * NWAVES + wave] = s; }
            __syncthreads();
            if (tid < 47) { float s = 0.f;
#pragma unroll
                for (int w = 0; w < NWAVES; ++w) s += part[tid * NWAVES + w];
                rs[tid] = 1.f / sqrtf(s * (1.f / DM) + RMS_EPS); }
            __syncthreads();
            bf16_t* po = POOLED + ((size_t)grp * S + rb) * 512 + (c4 & 511);
#define POOL_BODY(W) do { f32x4 s4 = (f32x4){0.f, 0.f, 0.f, 0.f}; \
            _Pragma("unroll") for (int j = 1; j < (W); ++j) s4 += h[j - 1] * rs[15 - j]; \
            _Pragma("unroll") for (int i = 0; i < 32; ++i) { const int t = rb + i; const f32x4 vi = v[i] * rs[15 + i]; \
                s4 += vi; \
                const float rc = 1.f / (float)((t + 1 < (W)) ? (t + 1) : (W)); \
                const f32x4 p = (s4 * rc - vi) * g4; \
                s4 -= ((i - (W) + 1 >= 0) ? v[(i - (W) + 1 >= 0) ? i - (W) + 1 : 0] : h[((W) - 2 - i >= 0) ? (W) - 2 - i : 0]) * rs[15 + i - (W) + 1];        \
                u32x2 w; w.x = cvt_pk_bf16(p.x, p.y); w.y = cvt_pk_bf16(p.z, p.w); \
                *(u32x2*)(po + (size_t)i * 512) = w; } } while (0)
            if (grp == 0) POOL_BODY(2); else if (grp == 1) POOL_BODY(4); else if (grp == 2) POOL_BODY(8); else POOL_BODY(16);
#undef POOL_BODY
            __syncthreads();
        }
    }
    SEAM(11);

    PHASE(12) {
        pg8::SchedPool Sd{(const char*)POOLED, (const char*)WPOOL, S / 256, DM / 256, F.G, gcid, (size_t)256 * 512 * 2, (size_t)S * 512 * 2};
        pg8::EpiResid E{X2, X3, DM, args.in[15], 1.f};
        pg8::gemm_phase(F.lds, 512 * 2, 8, Sd, E);
    }
    SEAM(12);

    PHASE(13) {
        const int RB = S / F.G, r0 = F.vcu * RB;
        LAS unsigned* es = (LAS unsigned*)F.lds;
        const float* gain = args.in[16]; const float* router = args.in[17];
        for (int ib = 4 * wave; ib < RB; ib += 4 * NWAVES) {
            float ss[4], lg[4][8];
#pragma unroll
            for (int q = 0; q < 4; ++q) { ss[q] = 0.f;
#pragma unroll
                for (int e = 0; e < 8; ++e) lg[q][e] = 0.f; }
            f32x4 xn[4];
#pragma unroll
            for (int q = 0; q < 4; ++q) xn[q] = *(const f32x4*)(X3 + (size_t)(r0 + ib + q) * DM + 4 * lane);
#pragma unroll 1
            for (int j = 0; j < 8; ++j) { const int k0 = 4 * (lane + 64 * j); const f32x4 g = *(const f32x4*)(gain + k0);
                f32x4 rr[4][2];
#pragma unroll
                for (int c = 0; c < 4; ++c) { rr[c][0] = *(const f32x4*)(router + (size_t)(k0 + c) * 8); rr[c][1] = *(const f32x4*)(router + (size_t)(k0 + c) * 8 + 4); }
                f32x4 xq[4];
#pragma unroll
                for (int q = 0; q < 4; ++q) xq[q] = xn[q];
                if (j < 7) {
#pragma unroll
                    for (int q = 0; q < 4; ++q) xn[q] = *(const f32x4*)(X3 + (size_t)(r0 + ib + q) * DM + k0 + 256); }
#pragma unroll
                for (int q = 0; q < 4; ++q) { const f32x4 x = xq[q]; ss[q] += (x.x * x.x + x.y * x.y) + (x.z * x.z + x.w * x.w); xq[q] = x * g; }
#pragma unroll
                for (int c = 0; c < 4; ++c) { const f32x4 ra = rr[c][0], rb = rr[c][1];
#pragma unroll
                    for (int q = 0; q < 4; ++q) { const float hv = xq[q][c];
                        lg[q][0] += hv * ra.x; lg[q][1] += hv * ra.y; lg[q][2] += hv * ra.z; lg[q][3] += hv * ra.w; lg[q][4] += hv * rb.x; lg[q][5] += hv * rb.y; lg[q][6] += hv * rb.z; lg[q][7] += hv * rb.w; } } }
            float rstd[4];
#pragma unroll
            for (int q = 0; q < 4; ++q) rstd[q] = 1.f / sqrtf(wave_sum(ss[q]) * (1.f / DM) + RMS_EPS);
#pragma unroll
            for (int q = 0; q < 4; ++q) { const int t = r0 + ib + q;
#pragma unroll
                for (int e = 0; e < 8; ++e) lg[q][e] = wave_sum(lg[q][e]) * rstd[q];
                int e1 = 0; float v1 = lg[q][0];
#pragma unroll
                for (int e = 1; e < 8; ++e) if (lg[q][e] > v1) { v1 = lg[q][e]; e1 = e; }
                int e2 = -1; float v2 = -__builtin_inff();
#pragma unroll
                for (int e = 0; e < 8; ++e) if (e != e1 && lg[q][e] > v2) { v2 = lg[q][e]; e2 = e; }
                const float g1 = 1.f / (1.f + __expf(v2 - v1)), g2 = 1.f - g1;
                if (lane == 0) { TOKE[t] = (unsigned)e1 | ((unsigned)e2 << 8); TOKG[t] = (f32x2){g1, g2}; RSTD3[t] = rstd[q]; es[ib + q] = (unsigned)e1 | ((unsigned)e2 << 8); } }
        }
        __syncthreads();
        if (tid < 8) { unsigned c = 0; for (int i = 0; i < RB; ++i) { const unsigned w = es[i]; c += ((w & 255u) == (unsigned)tid) + (((w >> 8) & 255u) == (unsigned)tid); } CNT[F.vcu * 8 + tid] = c; }
        __syncthreads();
    }
    SEAM(13);

    PHASE(14) {
        const int RB = S / F.G, r0 = F.vcu * RB;
        LAS unsigned* cnts = (LAS unsigned*)F.lds;
        LAS unsigned* tot = cnts + 2048; LAS unsigned* offs = tot + 8; LAS unsigned* base = offs + 8; LAS unsigned* es = base + 8; LAS unsigned* sl = es + 64;
        for (int i = tid; i < F.G * 8; i += NTHREADS) cnts[i] = CNT[i];
        if (tid < RB) es[tid] = TOKE[r0 + tid];
        __syncthreads();
        { unsigned t_ = 0, o_ = 0;
          for (int w = lane; w < F.G; w += 64) { const unsigned c = cnts[w * 8 + wave]; t_ += c; if (w < F.vcu) o_ += c; }
#pragma unroll
          for (int o = 1; o < 64; o <<= 1) { t_ += __shfl_xor(t_, o); o_ += __shfl_xor(o_, o); }
          if (lane == 0) { tot[wave] = t_; offs[wave] = o_; } }
        __syncthreads();
        if (tid == 0) { unsigned b = 0; for (int e = 0; e < 8; ++e) { base[e] = b; b += (tot[e] + 255u) & ~255u; }
            if (blockIdx.x == 0) { int pm = 0; for (int e = 0; e < 8; ++e) { const int nt_ = (int)((tot[e] + 255u) >> 8); for (int i = 0; i < nt_; ++i) TEXP[pm++] = e; } TEXP[127] = pm; { int cu = 0; for (int e = 0; e < 7; ++e) { cu += (int)((tot[e] + 255u) >> 8); TEXP[112 + e] = cu; } } } }
        __syncthreads();
        if (tid < RB) { const unsigned w = es[tid]; const unsigned e1 = w & 255u, e2 = (w >> 8) & 255u; unsigned k1 = 0, k2 = 0;
            for (int i = 0; i < tid; ++i) { const unsigned o = es[i]; const unsigned a = o & 255u, b = (o >> 8) & 255u; k1 += (a == e1) + (b == e1); k2 += (a == e2) + (b == e2); }
            const unsigned s1 = base[e1] + offs[e1] + k1, s2 = base[e2] + offs[e2] + k2;
            sl[2 * tid] = s1; sl[2 * tid + 1] = s2; SLOT[r0 + tid] = (u32x2){s1, s2}; }
        __syncthreads();
        const float* gain = args.in[16];
        for (int i0 = wave; i0 < RB; i0 += 4 * NWAVES) {
            f32x4 xv[4][8]; float rstd4[4];
#pragma unroll
            for (int q = 0; q < 4; ++q) { const int i = i0 + NWAVES * q, t = r0 + ((i < RB) ? i : i0); rstd4[q] = RSTD3[t] * F8_HSCALE;
                const f32x4* xr = (const f32x4*)(X3 + (size_t)t * DM) + lane;
#pragma unroll
                for (int j = 0; j < 8; ++j) xv[q][j] = xr[64 * j]; }
            const f32x4* gr = (const f32x4*)gain + lane;
#pragma unroll
            for (int q = 0; q < 4; ++q) { const int i = i0 + NWAVES * q;
                if (i < RB) { unsigned* o1 = (unsigned*)(HS8 + (size_t)sl[2 * i] * DM) + lane; unsigned* o2 = (unsigned*)(HS8 + (size_t)sl[2 * i + 1] * DM) + lane; const float rstd = rstd4[q];
#pragma unroll
                    for (int j = 0; j < 8; ++j) { const f32x4 v = xv[q][j], g = gr[64 * j]; const unsigned w = pk4_fp8(v.x * rstd * g.x, v.y * rstd * g.y, v.z * rstd * g.z, v.w * rstd * g.w); o1[64 * j] = w; o2[64 * j] = w; } } } }
        if (blockIdx.x < 8) { const int e = blockIdx.x; const unsigned p0 = base[e] + tot[e], p1 = base[e] + ((tot[e] + 255u) & ~255u);
            for (unsigned r = p0 + wave; r < p1; r += NWAVES) { u32x2* o = (u32x2*)(HS8 + (size_t)r * DM) + lane;
#pragma unroll
                for (int j = 0; j < 4; ++j) o[64 * j] = (u32x2){0u, 0u}; } }
        __syncthreads();
        { unsigned* const cq = (unsigned*)(ws + WS_CTL) + 3072;
          for (;;) {
            if (tid == 0) MISC[15] = __hip_atomic_fetch_add(cq, 4u, __ATOMIC_RELAXED, __HIP_MEMORY_SCOPE_AGENT);
            __syncthreads();
            const unsigned b0 = MISC[15];
            if (b0 >= (unsigned)MOE_NB) break;
#pragma unroll 1
            for (int q = 0; q < 4; ++q) if (b0 + q < (unsigned)MOE_NB) moe_cvt_batch(args.in[18], args.in[19], args.in[20], ws, (int)(b0 + q), wave, lane);
            __syncthreads();
            if (b0 + 4u >= (unsigned)MOE_NB_GU) break;
          } }
    }
    SEAM(14);

    PHASE(15) {
        const int ntile = __builtin_amdgcn_readfirstlane(TEXP[127]);
        pg8::ExpCum cum; { const int cv = (lane < 7) ? TEXP[112 + lane] : 0;
#pragma unroll
            for (int j = 0; j < 7; ++j) cum.c[j] = __builtin_amdgcn_readlane(cv, j); }
        pg8::SchedMoe Sd{(const char*)HS8, (const char*)MWGU8, cum, ntile, 2 * DFFE / 256, F.G, gcid, (size_t)256 * DM, (size_t)14336 * DM, 0};
        pg8::EpiSwigluF8 E{ACTM8, DFFE, 1.f / (F8_HSCALE * F8_WSCALE), F8_ASCALE};
        pg8::gemm_phase<pg8::EpiSwigluF8, pg8::SchedMoe, true>(F.lds, DM, DM / 128, Sd, E);
        { unsigned* const cq = (unsigned*)(ws + WS_CTL) + 3072;
          for (;;) {
            __syncthreads();
            if (tid == 0) MISC[15] = __hip_atomic_fetch_add(cq, 4u, __ATOMIC_RELAXED, __HIP_MEMORY_SCOPE_AGENT);
            __syncthreads();
            const unsigned b0 = MISC[15];
            if (b0 >= (unsigned)MOE_NB) break;
#pragma unroll 1
            for (int q = 0; q < 4; ++q) if (b0 + q < (unsigned)MOE_NB) moe_cvt_batch(args.in[18], args.in[19], args.in[20], ws, (int)(b0 + q), wave, lane);
          } }
    }
    SEAM(15);

    PHASE(16) {
        const int ntile = __builtin_amdgcn_readfirstlane(TEXP[127]);
        pg8::ExpCum cum; { const int cv = (lane < 7) ? TEXP[112 + lane] : 0;
#pragma unroll
            for (int j = 0; j < 7; ++j) cum.c[j] = __builtin_amdgcn_readlane(cv, j); }
        const int nsplit = ntile & 31;
        { pg8::SchedMoe Sd{(const char*)ACTM8, (const char*)MWDN8, cum, ntile - nsplit, DM / 256, F.G, gcid, (size_t)256 * DFFE, (size_t)DM * DFFE, 0};
          pg8::EpiStoreBf16 E{YM, DM, 1.f / (F8_ASCALE * F8_WSCALE)};
          pg8::gemm_phase<pg8::EpiStoreBf16, pg8::SchedMoe, true>(F.lds, DFFE, DFFE / 128, Sd, E); }
        if (nsplit > 0 && nsplit <= 8) {
          pg8::SchedMoeSplit Sd{(const char*)ACTM8, (const char*)MWDN8, cum, ntile - nsplit, 32 * nsplit, F.G, gcid, (size_t)256 * DFFE, (size_t)DM * DFFE, (size_t)(DFFE / 4)};
          pg8::EpiResid E{nullptr, YMP, DM, nullptr, 1.f / (F8_ASCALE * F8_WSCALE)};
          pg8::gemm_phase<pg8::EpiResid, pg8::SchedMoeSplit, true>(F.lds, DFFE, DFFE / 4 / 128, Sd, E); }
        else if (nsplit > 8) {
          pg8::SchedMoe Sd{(const char*)ACTM8 + (size_t)(ntile - nsplit) * 256 * DFFE, (const char*)MWDN8, cum, nsplit, DM / 256, F.G, gcid, (size_t)256 * DFFE, (size_t)DM * DFFE, ntile - nsplit};
          pg8::EpiStoreBf16 E{YM + (size_t)(ntile - nsplit) * 256 * DM, DM, 1.f / (F8_ASCALE * F8_WSCALE)};
          pg8::gemm_phase<pg8::EpiStoreBf16, pg8::SchedMoe, true>(F.lds, DFFE, DFFE / 128, Sd, E); }
    }
    SEAM(16);

    PHASE(17) {
        const int ntile = __builtin_amdgcn_readfirstlane(TEXP[127]); const int nsp = ntile & 31, sbase = (nsp > 0 && nsp <= 8) ? (ntile - nsp) * 256 : (1 << 30);
        for (int t = gw; t < S; t += NGW) { const u32x2 sl = SLOT[t]; const f32x2 g = TOKG[t];
            const f32x4* xr = (const f32x4*)(X3 + (size_t)t * DM) + lane; f32x4* o = (f32x4*)(args.out + (size_t)t * DM) + lane;
            f32x4 y[2][8];
#pragma unroll
            for (int q = 0; q < 2; ++q) { const int s_ = (int)(q ? sl.y : sl.x);
                if (s_ < sbase) { const u32x2* yp = (const u32x2*)(YM + (size_t)s_ * DM) + lane;
#pragma unroll
                    for (int j = 0; j < 8; ++j) { const u32x2 w = yp[64 * j]; y[q][j] = (f32x4){bf_lo(w.x), bf_hi(w.x), bf_lo(w.y), bf_hi(w.y)}; } }
                else { const f32x4* yp = (const f32x4*)(YMP + (size_t)(s_ - sbase) * DM) + lane;
#pragma unroll
                    for (int j = 0; j < 8; ++j) y[q][j] = (yp[64 * j] + yp[64 * j + (size_t)2048 * DM / 4]) + (yp[64 * j + (size_t)2 * 2048 * DM / 4] + yp[64 * j + (size_t)3 * 2048 * DM / 4]); } }
#pragma unroll
            for (int j = 0; j < 8; ++j) o[64 * j] = xr[64 * j] + (y[0][j] * g.x + y[1][j] * g.y); }
    }
#undef IN
#undef SEAM
}

extern "C" void kernel_launch(void* const* d_in, const int* in_sizes, int n_in, void* d_out, int out_size, void* d_ws, size_t ws_size, hipStream_t stream) {
    static int grid = 0;
    if (grid == 0) {
        if (n_in != 21 || in_sizes[0] != S * DM || out_size != S * DM || ws_size < WS_END) { fprintf(stderr, "kernel_launch: unexpected shapes (n_in %d, in0 %d, out %d, ws %zu)\n", n_in, n_in > 0 ? in_sizes[0] : -1, out_size, ws_size); grid = -1; return; }
        int dev = 0, cus = 0, per_cu = 0;
        if (hipGetDevice(&dev) != hipSuccess || hipDeviceGetAttribute(&cus, hipDeviceAttributeMultiprocessorCount, dev) != hipSuccess) { grid = -1; return; }
        if (hipFuncSetAttribute((const void*)mega_fwd, hipFuncAttributeMaxDynamicSharedMemorySize, LDS_BYTES) != hipSuccess) { fprintf(stderr, "kernel_launch: hipFuncSetAttribute failed\n"); grid = -1; return; }
        if (hipOccupancyMaxActiveBlocksPerMultiprocessor(&per_cu, (const void*)mega_fwd, NTHREADS, LDS_BYTES) != hipSuccess || per_cu < 1) fprintf(stderr, "kernel_launch: occupancy query reports %d\n", per_cu);
        (void)hipGetLastError();
        grid = cus;
        while (grid > 1 && (S % grid != 0 || grid > 256)) --grid;
    }
    if (grid < 0) return;
    (void)hipMemsetAsync((char*)d_ws + WS_CTL, 0, CTL_ZERO_BYTES, stream);
    Args a{};
    for (int i = 0; i < 21; ++i) a.in[i] = (const float*)d_in[i];
    a.out = (float*)d_out; a.ws = (unsigned char*)d_ws;
#if MK_FUSED
#if MK_PROBE_HI > 0
    a.ph_lo = 0; a.ph_hi = MK_PROBE_HI;
    hipLaunchKernelGGL(mega_fwd, dim3(grid), dim3(NTHREADS), LDS_BYTES, stream, a);
    (void)hipMemsetAsync((char*)d_ws + WS_CTL, 0, CTL_ZERO_BYTES, stream);
    a.ph_lo = MK_PROBE_LO; a.ph_hi = 18;
    hipLaunchKernelGGL(mega_fwd, dim3(grid), dim3(NTHREADS), LDS_BYTES, stream, a);
#else
    a.ph_lo = 0; a.ph_hi = 18;
    hipLaunchKernelGGL(mega_fwd, dim3(grid), dim3(NTHREADS), LDS_BYTES, stream, a);
#endif
#else
    for (int p = 0; p < 18; ++p) { a.ph_lo = p; a.ph_hi = p + 1; hipLaunchKernelGGL(mega_fwd, dim3(grid), dim3(NTHREADS), LDS_BYTES, stream, a); }
#endif
}
```

```cpp
#include <hip/hip_runtime.h>
#include <cstdio>
#include <cstdint>

#ifndef MK_ATT_MODES
#define MK_ATT_MODES 3
#endif
#ifndef MK_NAIVE_ATTN
#define MK_NAIVE_ATTN 0
#endif
#ifndef MK_PROBE_HI
#define MK_PROBE_LO 0
#define MK_PROBE_HI 0
#endif
#ifndef MK_FUSED
#define MK_FUSED 1
#endif

#define GAS __attribute__((address_space(1)))
#define LAS __attribute__((address_space(3)))
typedef unsigned short bf16_t;
typedef short bf16x8 __attribute__((ext_vector_type(8)));
typedef float f32x4 __attribute__((ext_vector_type(4)));
typedef float f32x2 __attribute__((ext_vector_type(2)));
typedef float f32x16 __attribute__((ext_vector_type(16)));
typedef unsigned u32x4 __attribute__((ext_vector_type(4)));
typedef unsigned u32x2 __attribute__((ext_vector_type(2)));
typedef int i32x4 __attribute__((ext_vector_type(4)));
typedef int i32x8 __attribute__((ext_vector_type(8)));

extern "C" __device__ int wl_i32(int, int, int) __asm("llvm.amdgcn.writelane.i32");
#define LDS_WAIT() asm volatile("s_waitcnt lgkmcnt(0)" ::: "memory")
#define VM_WAIT() asm volatile("s_waitcnt vmcnt(0)" ::: "memory")

constexpr int S = 8192, DM = 2048, NINP = 8448  , DFF = 5632, DFFE = 7168, NEXP = 8;
constexpr int NH = 8, HD = 128, NIH = 16, IDD = 64, TOPK = 256;
constexpr int MAXSLOT = 18432;
constexpr float RMS_EPS = 1e-6f;
constexpr float ATT_SCALE = 0.08838834764831845f;
constexpr int NWAVES = 8, NTHREADS = 512;

constexpr int C_QA = 0, C_KA = 1024, C_VA = 2048, C_QI = 3072, C_QB = 4096, C_KB = 5120, C_VB = 6144, C_GB = 7168, C_KI = 8192, C_WI = 8256, C_FB = 8272;

constexpr size_t MiB = 1u << 20;
constexpr size_t WS_CTL = 0, CTL_ZERO_BYTES = 32 * 1024;
constexpr size_t WS_WI = 1 * MiB;
constexpr size_t WS_LOGF = 1 * MiB + 512 * 1024;
constexpr size_t WS_CC = 1 * MiB + 768 * 1024;
constexpr size_t WS_TOKE = 2 * MiB;
constexpr size_t WS_TOKG = 2 * MiB + 32 * 1024;
constexpr size_t WS_RSTD3 = 2 * MiB + 96 * 1024;
constexpr size_t WS_SLOT = 2 * MiB + 128 * 1024;
constexpr size_t WS_CNT = 2 * MiB + 192 * 1024;
constexpr size_t WS_TEXP = 2 * MiB + 200 * 1024;
constexpr size_t WS_KI = 3 * MiB;
constexpr size_t WS_QX = 4 * MiB;
constexpr size_t WS_KX = 5 * MiB;
constexpr size_t WS_NQB = 6 * MiB;
constexpr size_t WS_NKB = 6 * MiB + 256 * 1024;
constexpr size_t WS_JLO = 6 * MiB + 512 * 1024;
constexpr size_t WS_ROT = 7 * MiB;
constexpr size_t WS_WIN = 8 * MiB;
constexpr size_t WS_WOUT = 41 * MiB;
constexpr size_t WS_WGU = 49 * MiB;
constexpr size_t WS_WDN = 93 * MiB;
constexpr size_t WS_WPOOL = 115 * MiB;
constexpr size_t WS_MWGU = 117 * MiB;
constexpr size_t WS_MWDN = 565 * MiB;
constexpr size_t WS_BIG1 = 789 * MiB;
constexpr size_t WS_BIG2 = 1045 * MiB;
constexpr size_t WS_ATT = 1189 * MiB;
constexpr size_t WS_MASK = 1319 * MiB;
constexpr size_t WS_O = 1327 * MiB;
constexpr size_t WS_H = 1359 * MiB;
constexpr size_t WS_X1 = 1391 * MiB;
constexpr size_t WS_X2 = 1455 * MiB;
constexpr size_t WS_YMP = 1520 * MiB;
constexpr size_t WS_PART = 1584 * MiB;
constexpr size_t WS_QLIN = 1617 * MiB;
constexpr size_t WS_END = 1618 * MiB;
constexpr int CW_BAR = 4096;

constexpr int RING_BYTES = 131072;
constexpr int MISC_OFF = RING_BYTES + 320;
constexpr int LDS_BYTES = 147456;

__device__ __forceinline__ unsigned cvt_pk_bf16(float lo, float hi) { unsigned r; asm volatile("v_cvt_pk_bf16_f32 %0, %1, %2" : "=v"(r) : "v"(lo), "v"(hi)); return r; }
__device__ __forceinline__ float bf_lo(unsigned w) { return __uint_as_float(w << 16); }
__device__ __forceinline__ float bf_hi(unsigned w) { return __uint_as_float(w & 0xffff0000u); }
__device__ __forceinline__ float bf1(bf16_t b) { return __uint_as_float(((unsigned)b) << 16); }
#define WS_DPP(v, ctrl) __builtin_bit_cast(float, __builtin_amdgcn_update_dpp(0, __builtin_bit_cast(int, (v)), (ctrl), 0xF, 0xF, true))
__device__ __forceinline__ float wave_sum(float v) {
    v += WS_DPP(v, 0xB1);
    v += WS_DPP(v, 0x4E);
    v += WS_DPP(v, 0x141);
    v += WS_DPP(v, 0x140);
    const int iv = __builtin_bit_cast(int, v);
    const float s0 = __builtin_bit_cast(float, __builtin_amdgcn_readlane(iv, 0)), s1 = __builtin_bit_cast(float, __builtin_amdgcn_readlane(iv, 16));
    const float s2 = __builtin_bit_cast(float, __builtin_amdgcn_readlane(iv, 32)), s3 = __builtin_bit_cast(float, __builtin_amdgcn_readlane(iv, 48));
    return (s0 + s1) + (s2 + s3);
}
__device__ __forceinline__ float sigmoidf_(float z) { return 1.f / (1.f + __expf(-z)); }
__device__ __forceinline__ unsigned pk4_fp8(float a, float b, float c, float d) {
    a = __builtin_amdgcn_fmed3f(a, -448.f, 448.f); b = __builtin_amdgcn_fmed3f(b, -448.f, 448.f); c = __builtin_amdgcn_fmed3f(c, -448.f, 448.f); d = __builtin_amdgcn_fmed3f(d, -448.f, 448.f);
    int w = __builtin_amdgcn_cvt_pk_fp8_f32(a, b, 0, false); w = __builtin_amdgcn_cvt_pk_fp8_f32(c, d, w, true); return (unsigned)w; }
constexpr float F8_WSCALE = 512.f, F8_HSCALE = 16.f, F8_ASCALE = 8.f;

#define XB_TMO      128
#define XB_XCNT(j)  (256  + 64 * (j))
#define XB_XSUB(j)  (1280 + 64 * (j))
#define XB_XGEN(j)  (2304 + 64 * (j))
#define XB_TOP      3328
#define XB_TOPGEN   3392
#define XCD_BAR_WORDS 3456
#define XB_SPIN_CAP (1u << 22)

__device__ __forceinline__ unsigned xb_ld(unsigned* p)              { return __hip_atomic_load(p, __ATOMIC_RELAXED, __HIP_MEMORY_SCOPE_AGENT); }
__device__ __forceinline__ unsigned xb_add(unsigned* p, unsigned v) { return __hip_atomic_fetch_add(p, v, __ATOMIC_RELAXED, __HIP_MEMORY_SCOPE_AGENT); }
__device__ __forceinline__ unsigned xb_xcc_id() { return (unsigned)__builtin_amdgcn_s_getreg((3 << 11) | 20) & 0xFu; }
#define XB_SPIN(cond, bar) do { unsigned _sp = 0; while (cond) { __builtin_amdgcn_s_sleep(1); \
    if ((++_sp & 255u) == 0u) { if (xb_ld(&(bar)[XB_TMO])) break; if (_sp > XB_SPIN_CAP) { atomicAdd(&(bar)[XB_TMO], 1u); break; } } } } while (0)

struct XcdBarrier { unsigned* bar; unsigned x; volatile LAS unsigned* st; };

__device__ __forceinline__ XcdBarrier xcd_barrier_post(unsigned* bar, volatile LAS unsigned* st) {
    XcdBarrier b; b.bar = bar; b.x = xb_xcc_id(); b.st = st;
    if (threadIdx.x == 0) (void)xb_add(&bar[XB_XCNT(b.x)], 1u);
    return b;
}
__device__ __forceinline__ void xcd_barrier_complete(unsigned* bar, unsigned x, unsigned& nloc, unsigned& nx) {
    const unsigned G = gridDim.x * gridDim.y * gridDim.z;
    unsigned sum, cnt, mine, sp = 0u;
    for (;;) {
        sum = 0u; cnt = 0u; mine = 0u;
#pragma unroll
        for (unsigned j = 0; j < 16; ++j) { const unsigned c = xb_ld(&bar[XB_XCNT(j)]); sum += c; cnt += (c > 0u) ? 1u : 0u; mine = (j == x) ? c : mine; }
        if (sum == G) break;
        __builtin_amdgcn_s_sleep(1);
        if ((++sp & 255u) == 0u) { if (xb_ld(&bar[XB_TMO])) break; if (sp > XB_SPIN_CAP) { atomicAdd(&bar[XB_TMO], 1u); break; } }
    }
    nloc = mine > 0u ? mine : 1u; nx = cnt > 0u ? cnt : 1u;
}
__device__ __forceinline__ void xcd_barrier(const XcdBarrier& b) {
    asm volatile("s_waitcnt vmcnt(0)" ::: "memory");
    __syncthreads();
    if (threadIdx.x == 0) {
        unsigned* bar = b.bar;
        __builtin_amdgcn_s_waitcnt(0);
        unsigned nloc = b.st[0], nx = b.st[1];
        if (nloc == 0u) { xcd_barrier_complete(bar, b.x, nloc, nx); b.st[0] = nloc; b.st[1] = nx; }
        const unsigned old = xb_add(&bar[XB_XSUB(b.x)], 1u);
        const unsigned gen = old / nloc;
        if (old + 1u == (gen + 1u) * nloc) {
            __builtin_amdgcn_fence(__ATOMIC_RELEASE, "agent");
            asm volatile("s_waitcnt vmcnt(0)" ::: "memory");
            const unsigned og = xb_add(&bar[XB_TOP], 1u);
            const unsigned tg = og / nx;
            if (og + 1u == (tg + 1u) * nx) xb_add(&bar[XB_TOPGEN], 1u);
            else XB_SPIN(xb_ld(&bar[XB_TOPGEN]) == tg, bar);
            __builtin_amdgcn_fence(__ATOMIC_ACQUIRE, "agent");
            xb_add(&bar[XB_XGEN(b.x)], 1u);
            asm volatile("s_waitcnt vmcnt(0)" ::: "memory");
        } else {
            XB_SPIN(xb_ld(&bar[XB_XGEN(b.x)]) == gen, bar);
            __builtin_amdgcn_fence(__ATOMIC_ACQUIRE, "agent");
            asm volatile("s_waitcnt vmcnt(0)" ::: "memory");
        }
    }
    __syncthreads();
}

namespace pg8 {
constexpr int BM = 256, BK = 64, HALF = 128, HTB = HALF * BK * 2, STAGE_BYTES = 8 * HTB, NXCD = 8, WGM = 8;
__host__ __device__ __forceinline__ int lds_byte(int r, int c) { const int st = (r >> 4) * 2 + (c >> 5), rr = r & 15, cc = c & 31, ob = rr * 64 + cc * 2; return st * 1024 + (ob ^ (((ob >> 9) & 1) << 5)); }
__host__ __device__ __forceinline__ void stage_rc(int b, int& R, int& C) { const int st = b / 1024, sb = b % 1024, swz = sb ^ (((sb >> 9) & 1) << 5); R = (st >> 1) * 16 + swz / 64; C = (st & 1) * 32 + (swz % 64) / 2; }
__host__ __device__ __forceinline__ int perm32(int rho) { const int n = rho >> 4, i = rho & 15; return 8 * (i >> 2) + 4 * n + (i & 3); }

__device__ __forceinline__ void glds16_s(const void* sbase, unsigned voff, unsigned lds_dst) {
    unsigned keep;
    asm volatile("s_mov_b32 %0, m0\n\ts_mov_b32 m0, %3\n\ts_nop 0\n\tglobal_load_lds_dwordx4 %1, %2\n\ts_mov_b32 m0, %0" : "=&s"(keep) : "v"(voff), "s"(sbase), "s"(lds_dst) : "memory");
}
struct Unit { int pm, pn; const char* A; const char* B; };

__device__ __forceinline__ bool order_tile(int i, int G, int c, int nM, int nN, int& pm, int& pn) {
    const int nwg = nM * nN; const int L = i * G + c; if (L >= nwg) return false;
    int wgid = L; { const int q = nwg / NXCD, r = nwg % NXCD, xcd = wgid % NXCD, off = wgid / NXCD; wgid = (xcd < r ? xcd * (q + 1) : r * (q + 1) + (xcd - r) * q) + off; }
    const int nig = WGM * nN, gid = wgid / nig, fm = gid * WGM, gsz = (nM - fm) < WGM ? (nM - fm) : WGM;
    pm = fm + ((wgid % nig) % gsz); pn = (wgid % nig) / gsz; return true;
}
struct SchedPlain {
    const char* A0; const char* B0; int nM, nN, G, c; size_t tstep;
    __device__ __forceinline__ bool next(int i, Unit& u) const { if (!order_tile(i, G, c, nM, nN, u.pm, u.pn)) return false; u.A = A0 + (size_t)u.pm * tstep; u.B = B0 + (size_t)u.pn * tstep; return true; }
};
struct SchedPool {
    const char* A0; const char* B0; int nM, nN, G, c; size_t tstep, groupA;
    __device__ __forceinline__ bool next(int i, Unit& u) const { if (!order_tile(i, G, c, nM, nN, u.pm, u.pn)) return false; u.A = A0 + (size_t)(u.pn >> 1) * groupA + (size_t)u.pm * tstep; u.B = B0 + (size_t)u.pn * tstep; return true; }
};
struct ExpCum { int c[7]; __device__ __forceinline__ int expert(int pm) const { int e = 0;
#pragma unroll
        for (int j = 0; j < 7; ++j) e += (pm >= c[j]) ? 1 : 0; return e; } };
struct SchedMoe {
    const char* A0; const char* B0; ExpCum cum; int nM, nN, G, c; size_t tstep, expB; int pm0;
    __device__ __forceinline__ bool next(int i, Unit& u) const { if (!order_tile(i, G, c, nM, nN, u.pm, u.pn)) return false; const int e = cum.expert(u.pm + pm0);
        u.A = A0 + (size_t)u.pm * tstep; u.B = B0 + (size_t)e * expB + (size_t)u.pn * tstep; return true; }
};

struct SchedMoeSplit {
    const char* A0; const char* B0; ExpCum cum; int base, nunits, G, c; size_t tstep, expB, kq_bytes;
    __device__ __forceinline__ bool next(int i, Unit& u) const { const int L = i * G + c; if (L >= nunits) return false;
        const int kq = L & 3, pn = (L >> 2) & 7, loc = L >> 5, pm = base + loc; const int e = cum.expert(pm);
        u.pm = kq * 8 + loc; u.pn = pn; u.A = A0 + (size_t)pm * tstep + (size_t)kq * kq_bytes; u.B = B0 + (size_t)e * expB + (size_t)pn * tstep + (size_t)kq * kq_bytes; return true; }
};

struct EpiStoreBf16 {
    static constexpr bool PERM = true;
    bf16_t* O; int ldc; float scale;
    __device__ __forceinline__ void operator()(const f32x4 (&acc)[2][2][4][2], const Unit& u, int wr, int wc, int fr, int fq) const {
        const int row0 = u.pm * BM + wr * 64 + fr, col0 = u.pn * BM + wc * 32 + 8 * fq;
#pragma unroll
        for (int ai = 0; ai < 2; ++ai)
#pragma unroll
            for (int m = 0; m < 4; ++m) { bf16_t* rowp = O + (size_t)(row0 + ai * HALF + m * 16) * ldc + col0;
#pragma unroll
                for (int bj = 0; bj < 2; ++bj) { const f32x4 v0 = acc[ai][bj][m][0] * scale, v1 = acc[ai][bj][m][1] * scale;
                    u32x4 w; w.x = cvt_pk_bf16(v0[0], v0[1]); w.y = cvt_pk_bf16(v0[2], v0[3]); w.z = cvt_pk_bf16(v1[0], v1[1]); w.w = cvt_pk_bf16(v1[2], v1[3]);
                    *(u32x4*)(rowp + bj * HALF) = w; } }
    }
};
struct EpiInProj {
    static constexpr bool PERM = true;
    bf16_t* O; int ldc; bf16_t* VAo; bf16_t* VBo; bf16_t* GBo;
    __device__ __forceinline__ void operator()(const f32x4 (&acc)[2][2][4][2], const Unit& u, int wr, int wc, int fr, int fq) const {
        const int row0 = u.pm * BM + wr * 64 + fr, seg = u.pn >> 2, scol0 = (u.pn & 3) * BM + wc * 32 + 8 * fq;
        const int kind = (seg == 2 || seg == 6) ? 1 : ((seg == 7) ? 2 : 0);
        bf16_t* const Vb = (seg == 2) ? VAo : VBo;
#pragma unroll
        for (int ai = 0; ai < 2; ++ai)
#pragma unroll
            for (int m = 0; m < 4; ++m) { const int row = row0 + ai * HALF + m * 16;
#pragma unroll
                for (int bj = 0; bj < 2; ++bj) { f32x4 v0 = acc[ai][bj][m][0], v1 = acc[ai][bj][m][1]; const int sc = scol0 + bj * HALF;
                    bf16_t* p;
                    if (kind == 1) p = Vb + ((size_t)(sc >> 7) * S + row) * HD + (sc & 127);
                    else if (kind == 2) { p = GBo + (size_t)row * 1024 + sc;
#pragma unroll
                        for (int j = 0; j < 4; ++j) { v0[j] = __builtin_amdgcn_rcpf(1.f + __builtin_amdgcn_exp2f(-1.4426950408889634f * v0[j])); v1[j] = __builtin_amdgcn_rcpf(1.f + __builtin_amdgcn_exp2f(-1.4426950408889634f * v1[j])); } }
                    else p = O + (size_t)row * ldc + u.pn * BM + bj * HALF + wc * 32 + 8 * fq;
                    u32x4 w; w.x = cvt_pk_bf16(v0[0], v0[1]); w.y = cvt_pk_bf16(v0[2], v0[3]); w.z = cvt_pk_bf16(v1[0], v1[1]); w.w = cvt_pk_bf16(v1[2], v1[3]);
                    *(u32x4*)p = w; } }
    }
};
struct EpiSwiglu {
    static constexpr bool PERM = true;
    bf16_t* O; int ldc;
    __device__ __forceinline__ void operator()(const f32x4 (&acc)[2][2][4][2], const Unit& u, int wr, int wc, int fr, int fq) const {
        const int row0 = u.pm * BM + wr * 64 + fr, col0 = u.pn * HALF + wc * 32 + 8 * fq;
#pragma unroll
        for (int ai = 0; ai < 2; ++ai)
#pragma unroll
            for (int m = 0; m < 4; ++m) { bf16_t* rowp = O + (size_t)(row0 + ai * HALF + m * 16) * ldc + col0;
                f32x4 v[2];
#pragma unroll
                for (int n = 0; n < 2; ++n) { const f32x4 g = acc[ai][0][m][n], up = acc[ai][1][m][n];
#pragma unroll
                    for (int j = 0; j < 4; ++j) { const float e = __builtin_amdgcn_exp2f(-1.4426950408889634f * g[j]); v[n][j] = g[j] * __builtin_amdgcn_rcpf(1.f + e) * up[j]; } }
                u32x4 w; w.x = cvt_pk_bf16(v[0][0], v[0][1]); w.y = cvt_pk_bf16(v[0][2], v[0][3]); w.z = cvt_pk_bf16(v[1][0], v[1][1]); w.w = cvt_pk_bf16(v[1][2], v[1][3]);
                *(u32x4*)rowp = w; }
    }
};
struct EpiSwigluF8 {
    static constexpr bool PERM = true;
    unsigned char* O; int ldc; float sin_, sout;
    __device__ __forceinline__ void operator()(const f32x4 (&acc)[2][2][4][2], const Unit& u, int wr, int wc, int fr, int fq) const {
        const int row0 = u.pm * BM + wr * 64 + fr, col0 = u.pn * HALF + wc * 32 + 8 * fq;
#pragma unroll
        for (int ai = 0; ai < 2; ++ai)
#pragma unroll
            for (int m = 0; m < 4; ++m) { unsigned char* rowp = O + (size_t)(row0 + ai * HALF + m * 16) * ldc + col0;
                f32x4 v[2];
#pragma unroll
                for (int n = 0; n < 2; ++n) { const f32x4 g = acc[ai][0][m][n] * sin_, up = acc[ai][1][m][n] * (sin_ * sout);
#pragma unroll
                    for (int j = 0; j < 4; ++j) { const float e = __builtin_amdgcn_exp2f(-1.4426950408889634f * g[j]); v[n][j] = g[j] * __builtin_amdgcn_rcpf(1.f + e) * up[j]; } }
                u32x2 w; w.x = pk4_fp8(v[0][0], v[0][1], v[0][2], v[0][3]); w.y = pk4_fp8(v[1][0], v[1][1], v[1][2], v[1][3]);
                *(u32x2*)rowp = w; }
    }
};
struct EpiResid {
    static constexpr bool PERM = false;
    const float* res; float* out; int ldc; const float* cscale; float ascale;
    __device__ __forceinline__ void operator()(const f32x4 (&acc)[2][2][4][2], const Unit& u, int wr, int wc, int fr, int fq) const {
        const int row0 = u.pm * BM + wr * 64 + fr, col0 = u.pn * BM + wc * 32 + 4 * fq;
        f32x4 cs[2][2];
#pragma unroll
        for (int bj = 0; bj < 2; ++bj)
#pragma unroll
            for (int n = 0; n < 2; ++n) cs[bj][n] = (cscale ? *(const f32x4*)(cscale + col0 + bj * HALF + n * 16) : (f32x4){1.f, 1.f, 1.f, 1.f}) * ascale;
#pragma unroll
        for (int ai = 0; ai < 2; ++ai)
#pragma unroll
            for (int m = 0; m < 4; ++m) { const size_t off = (size_t)(row0 + ai * HALF + m * 16) * ldc + col0;
#pragma unroll
                for (int bj = 0; bj < 2; ++bj)
#pragma unroll
                    for (int n = 0; n < 2; ++n) { f32x4 v = acc[ai][bj][m][n] * cs[bj][n];
                        if (res) v += *(const f32x4*)(res + off + bj * HALF + n * 16);
                        *(f32x4*)(out + off + bj * HALF + n * 16) = v; }
                asm volatile("" ::: "memory"); }
    }
};

template <class Epi, class Sched, bool FP8 = false>
__device__ __forceinline__ void gemm_phase(LAS unsigned char* lds, const int Kb, const int nt  , const Sched& S, const Epi& E) {
    const int tid = threadIdx.x, wid = __builtin_amdgcn_readfirstlane(tid >> 6), lane = tid & 63, wr = wid >> 2, wc = wid & 3, fr = lane & 15, fq = lane >> 4;
    unsigned voffA, voffB;
    { int R, C; stage_rc(tid * 16, R, C); const int Rb = Epi::PERM ? ((R & ~31) + perm32(R & 31)) : R;
        voffA = (unsigned)(R * Kb + C * 2); voffB = (unsigned)(Rb * Kb + C * 2); }
    const size_t r64 = (size_t)64 * Kb;
    const size_t kstep = (size_t)(BK * 2);
    const size_t hstep = (size_t)HALF * Kb;
    const unsigned ldsw = (unsigned)wid * 1024u, ldsb = (unsigned)(uintptr_t)lds;
    const int aoff = lds_byte(wr * 64 + fr, fq * 8), boff = lds_byte(wc * 32 + fr, fq * 8);
#define PG8_SA(b, h) (((b) * 2 + (h)) * HTB)
#define PG8_SB(b, h) ((4 + (b) * 2 + (h)) * HTB)
#define PG8_STAGE(bufoff, gbase, voff) do { _Pragma("unroll") for (int _i = 0; _i < 2; ++_i) glds16_s((const void*)((const char*)(gbase) + _i * r64), (voff), ldsb + (unsigned)(bufoff) + ldsw + _i * 8192u); } while (0)
#define PG8_LD16(off) (*(const LAS bf16x8*)(lds + (off)))
#define PG8_CAT8(o_) __builtin_shufflevector(__builtin_bit_cast(i32x4, PG8_LD16(o_)), __builtin_bit_cast(i32x4, PG8_LD16((o_) + 1024)), 0, 1, 2, 3, 4, 5, 6, 7)
#define PG8_LDA(b, h) do { _Pragma("unroll") for (int m = 0; m < 4; ++m) { const int o_ = PG8_SA(b, h) + aoff + m * 2048; \
        if constexpr (FP8) A8[m] = PG8_CAT8(o_); else { At[m][0] = PG8_LD16(o_); At[m][1] = PG8_LD16(o_ + 1024); } } } while (0)
#define PG8_LDB(X, X8, b, h) do { _Pragma("unroll") for (int n = 0; n < 2; ++n) { const int o_ = PG8_SB(b, h) + boff + n * 2048; \
        if constexpr (FP8) X8[n] = PG8_CAT8(o_); else { X[n][0] = PG8_LD16(o_); X[n][1] = PG8_LD16(o_ + 1024); } } } while (0)
#define PG8_MMA(ai, bj, X, X8) do { if constexpr (!FP8) __builtin_amdgcn_s_setprio(1); _Pragma("unroll") for (int m = 0; m < 4; ++m) _Pragma("unroll") for (int n = 0; n < 2; ++n) { \
        if constexpr (FP8) acc[ai][bj][m][n] = __builtin_amdgcn_mfma_scale_f32_16x16x128_f8f6f4(X8[n], A8[m], acc[ai][bj][m][n], 0, 0, 0, 0x7f7f7f7f, 0, 0x7f7f7f7f); \
        else { _Pragma("unroll") for (int k = 0; k < 2; ++k) acc[ai][bj][m][n] = __builtin_amdgcn_mfma_f32_16x16x32_bf16(X[n][k], At[m][k], acc[ai][bj][m][n], 0, 0, 0); } } \
        if constexpr (!FP8) __builtin_amdgcn_s_setprio(0); } while (0)
#define PG8_WAIT_V(n) asm volatile("s_waitcnt vmcnt(" #n ")" ::: "memory")
#define PG8_WAIT_L(n) asm volatile("s_waitcnt lgkmcnt(" #n ")" ::: "memory")
#define PG8_BAR __builtin_amdgcn_s_barrier()
#define PG8_SCHED __builtin_amdgcn_sched_barrier(0)
#define PG8_HI do { if constexpr (FP8) asm volatile("s_setprio 1"); } while (0)
#define PG8_LO do { if constexpr (FP8) asm volatile("s_setprio 0"); } while (0)
    Unit cur, nxt; int ui = 0;
    if (!S.next(0, cur)) return;
    f32x4 acc[2][2][4][2];
#pragma unroll
    for (int a = 0; a < 2; ++a)
#pragma unroll
        for (int b = 0; b < 2; ++b)
#pragma unroll
            for (int m = 0; m < 4; ++m)
#pragma unroll
                for (int n = 0; n < 2; ++n) acc[a][b][m][n] = (f32x4){0.f, 0.f, 0.f, 0.f};
    bf16x8 At[4][2], B0[2][2], B1[2][2]; i32x8 A8[4], B08[2], B18[2];
    const char* cA = cur.A; const char* cB = cur.B;
    PG8_STAGE(PG8_SB(0, 0), cB, voffB); PG8_STAGE(PG8_SA(0, 0), cA, voffA); PG8_STAGE(PG8_SB(0, 1), cB + hstep, voffB); PG8_STAGE(PG8_SA(0, 1), cA + hstep, voffA);
    if (wr == 1) PG8_BAR;
    PG8_WAIT_V(4); PG8_BAR;
    PG8_STAGE(PG8_SB(1, 0), cB + kstep, voffB); PG8_STAGE(PG8_SA(1, 0), cA + kstep, voffA); PG8_STAGE(PG8_SB(1, 1), cB + hstep + kstep, voffB);
    PG8_WAIT_V(6); PG8_BAR;
    for (;;) {
        const bool has_next = S.next(ui + 1, nxt);
        const char* nA = has_next ? nxt.A : cA; const char* nB = has_next ? nxt.B : cB;
        for (int t = 0; t < nt; t += 2) {
            const bool last = (t == nt - 2);
            const char* a1 = cA + (size_t)(t + 1) * kstep;
            const char* a2 = last ? nA : cA + (size_t)(t + 2) * kstep; const char* b2 = last ? nB : cB + (size_t)(t + 2) * kstep;
            const char* a3 = a2 + kstep; const char* b3 = b2 + kstep;
            PG8_LDB(B0, B08, 0, 0); PG8_SCHED; PG8_LDA(0, 0); PG8_STAGE(PG8_SA(1, 1), a1 + hstep, voffA);
            PG8_WAIT_L(8); PG8_BAR; PG8_HI; PG8_WAIT_L(0); PG8_MMA(0, 0, B0, B08); PG8_BAR; PG8_LO; PG8_SCHED;
            PG8_LDB(B1, B18, 0, 1); PG8_STAGE(PG8_SB(0, 0), b2, voffB);
            PG8_BAR; PG8_HI; PG8_WAIT_L(0); PG8_MMA(0, 1, B1, B18); PG8_BAR; PG8_LO;
            PG8_LDA(0, 1); PG8_STAGE(PG8_SA(0, 0), a2, voffA);
            PG8_BAR; PG8_HI; PG8_WAIT_L(0); PG8_MMA(1, 0, B0, B08); PG8_BAR; PG8_LO; PG8_SCHED;
            PG8_STAGE(PG8_SB(0, 1), b2 + hstep, voffB);
            PG8_WAIT_V(6); PG8_BAR; PG8_HI; PG8_MMA(1, 1, B1, B18); PG8_BAR; PG8_LO;
            PG8_LDB(B0, B08, 1, 0); PG8_SCHED; PG8_LDA(1, 0); PG8_STAGE(PG8_SA(0, 1), a2 + hstep, voffA);
            PG8_WAIT_L(8); PG8_BAR; PG8_HI; PG8_WAIT_L(0); PG8_MMA(0, 0, B0, B08); PG8_BAR; PG8_LO; PG8_SCHED;
            PG8_LDB(B1, B18, 1, 1); PG8_STAGE(PG8_SB(1, 0), b3, voffB);
            PG8_BAR; PG8_HI; PG8_WAIT_L(0); PG8_MMA(0, 1, B1, B18); PG8_BAR; PG8_LO;
            PG8_LDA(1, 1); PG8_STAGE(PG8_SA(1, 0), a3, voffA);
            PG8_BAR; PG8_HI; PG8_WAIT_L(0); PG8_MMA(1, 0, B0, B08); PG8_BAR; PG8_LO; PG8_SCHED;
            PG8_STAGE(PG8_SB(1, 1), b3 + hstep, voffB);
            PG8_WAIT_V(6); PG8_BAR; PG8_HI; PG8_MMA(1, 1, B1, B18); PG8_BAR; PG8_LO;
        }
        { int l_; asm volatile("v_mbcnt_lo_u32_b32 %0, -1, 0\n\tv_mbcnt_hi_u32_b32 %0, -1, %0" : "=v"(l_));
          E(acc, cur, wr, wc, l_ & 15, l_ >> 4); }
        if (!has_next) break;
#pragma unroll
        for (int a = 0; a < 2; ++a)
#pragma unroll
            for (int b = 0; b < 2; ++b)
#pragma unroll
                for (int m = 0; m < 4; ++m)
#pragma unroll
                    for (int n = 0; n < 2; ++n) acc[a][b][m][n] = (f32x4){0.f, 0.f, 0.f, 0.f};
        cur = nxt; cA = nA; cB = nB; ++ui;
    }
    PG8_WAIT_V(0);
    if (wr == 0) PG8_BAR;
    PG8_BAR;
#undef PG8_SA
#undef PG8_SB
#undef PG8_STAGE
#undef PG8_LDA
#undef PG8_LDB
#undef PG8_MMA
#undef PG8_CAT8
#undef PG8_LD16
#undef PG8_WAIT_V
#undef PG8_WAIT_L
#undef PG8_BAR
#undef PG8_SCHED
#undef PG8_HI
#undef PG8_LO
}
}


namespace fa {
constexpr int QBLK = 32, KVBLK = 64, QB = 256, D = 128;
constexpr int SHM_V = 16384, SHM_K = 16384, SHM_X = 2048;
constexpr int OFF_V = 0, OFF_K = 2 * SHM_V, OFF_X = OFF_K + 2 * SHM_K, OFF_W = OFF_X + 2 * SHM_X;
constexpr float SCALE = 0.08838834764831845f, THR = 8.f;
typedef short s16x4 __attribute__((ext_vector_type(4)));
#define KSWZ(row, colB) ((row) * 256 + ((colB) ^ (((row) & 7) << 4)))
#define SBAR() __builtin_amdgcn_sched_barrier(0)
__device__ __forceinline__ int v_st(int k, int c) { const int kk = (k & ~0xC) | ((k & 4) << 1) | ((k & 8) >> 1); return ((kk >> 3) * 4 + (c >> 5)) * 512 + ((kk & 7) * 32 + (c & 31)) * 2; }
__device__ __forceinline__ int v_rd_base(int lane) { return ((lane & 3) << 3) | (((lane >> 2) & 3) << 6) | (((lane >> 4) & 1) << 5) | (((lane >> 5) & 1) << 8); }
constexpr int v_rd_off(int d0, int ks, int half) { return d0 * 512 + ks * 4096 + half * 2048; }
__device__ __forceinline__ int crow(int r, int hi) { return (r & 3) + 8 * (r >> 2) + 4 * hi; }
__device__ __forceinline__ void mask_causal(f32x16& p0, f32x16& p1, int dq) {
    const float NEG = -__builtin_inff();
#pragma unroll
    for (int r = 0; r < 16; ++r) { const int c = (r & 3) + 8 * (r >> 2); if (dq - c < 0) p0[r] = NEG; if (dq - c - 32 < 0) p1[r] = NEG; }
}
__device__ __forceinline__ void mask_bits(f32x16& p0, f32x16& p1, unsigned long long mw, int hi) {
    const unsigned lo = (unsigned)mw >> (4 * hi), hw = (unsigned)(mw >> 32) >> (4 * hi);
#pragma unroll
    for (int r = 0; r < 16; ++r) { const int c = (r & 3) + 8 * (r >> 2);
        const unsigned t0 = (unsigned)((int)(lo << (31 - c)) >> 31), t1 = (unsigned)((int)(hw << (31 - c)) >> 31);
        p0[r] = __uint_as_float((__float_as_uint(p0[r]) & t0) | (0xFF800000u & ~t0));
        p1[r] = __uint_as_float((__float_as_uint(p1[r]) & t1) | (0xFF800000u & ~t1)); }
}
__device__ __forceinline__ void partialSM(f32x16& p0, f32x16& p1, float& m_reg, float& mn, float& alpha) {
    float pmax = p0[0]; for (int r = 1; r < 16; ++r) pmax = fmaxf(pmax, p0[r]); for (int r = 0; r < 16; ++r) pmax = fmaxf(pmax, p1[r]);
    { auto rr = __builtin_amdgcn_permlane32_swap(__float_as_uint(pmax), __float_as_uint(pmax), false, false);
      pmax = fmaxf(__uint_as_float(rr[0]), __uint_as_float(rr[1])); }
    constexpr float C2 = 1.4426950408889634f * SCALE;
    if (__builtin_expect(__all((pmax - m_reg) * SCALE <= THR), 1)) { mn = m_reg; alpha = 1.f; }
    else { mn = fmaxf(m_reg, pmax); alpha = __builtin_amdgcn_exp2f((m_reg - mn) * C2); m_reg = mn; }
    const float mnL = -mn * C2;
    for (int r = 0; r < 16; ++r) p0[r] = fmaf(p0[r], C2, mnL); for (int r = 0; r < 16; ++r) p1[r] = fmaf(p1[r], C2, mnL);
    for (int r = 0; r < 16; ++r) p0[r] = __builtin_amdgcn_exp2f(p0[r]);
}
__device__ __forceinline__ void finishSM(f32x16& p0, f32x16& p1, float alpha, float& l_reg, bf16x8& pa0, bf16x8& pa1, bf16x8& pa2, bf16x8& pa3) {
    for (int r = 0; r < 16; ++r) p1[r] = __builtin_amdgcn_exp2f(p1[r]);
    float ps = 0; for (int r = 0; r < 16; ++r) ps += p0[r]; for (int r = 0; r < 16; ++r) ps += p1[r];
    { auto rr = __builtin_amdgcn_permlane32_swap(__float_as_uint(ps), __float_as_uint(ps), false, false);
      ps = __uint_as_float(rr[0]) + __uint_as_float(rr[1]); }
    l_reg = l_reg * alpha + ps;
#define PK4(P, B_, OUT) do { unsigned a0 = cvt_pk_bf16(P[B_+0], P[B_+1]), a1 = cvt_pk_bf16(P[B_+2], P[B_+3]);                          \
        unsigned b0 = cvt_pk_bf16(P[B_+4], P[B_+5]), b1 = cvt_pk_bf16(P[B_+6], P[B_+7]);                                             \
        auto r0 = __builtin_amdgcn_permlane32_swap(a0, b0, false, false); auto r1 = __builtin_amdgcn_permlane32_swap(a1, b1, false, false); \
        u32x4 w = {r0[0], r1[0], r0[1], r1[1]}; OUT = *reinterpret_cast<bf16x8*>(&w); } while (0)
    PK4(p0, 0, pa0); PK4(p0, 8, pa1); PK4(p1, 0, pa2); PK4(p1, 8, pa3);
#undef PK4
}
template <int KB, bool EXT>
__device__ __forceinline__ void qkt(f32x16& p0, f32x16& p1, const char* lds, int r32, int hi, const bf16x8* qr, bf16x8 qx) {
    p0 = f32x16{}; p1 = f32x16{};
    const char* kb[4];
#pragma unroll
    for (int dd = 0; dd < 4; ++dd) kb[dd] = lds + OFF_K + KB * SHM_K + KSWZ(r32, (dd * 16 + hi * 8) * 2);
#pragma unroll
    for (int d0 = 0; d0 < 8; ++d0) { const char* a = kb[d0 & 3] + (d0 >> 2) * 128;
        bf16x8 b0 = *reinterpret_cast<const bf16x8*>(a);
        bf16x8 b1 = *reinterpret_cast<const bf16x8*>(a + 32 * 256);
        p0 = __builtin_amdgcn_mfma_f32_32x32x16_bf16(b0, qr[d0], p0, 0, 0, 0);
        p1 = __builtin_amdgcn_mfma_f32_32x32x16_bf16(b1, qr[d0], p1, 0, 0, 0); }
    if (EXT) { const char* xa = lds + OFF_X + KB * SHM_X + r32 * 32 + hi * 16;
        bf16x8 x0 = *reinterpret_cast<const bf16x8*>(xa), x1 = *reinterpret_cast<const bf16x8*>(xa + 32 * 32);
        p0 = __builtin_amdgcn_mfma_f32_32x32x16_bf16(x0, qx, p0, 0, 0, 0);
        p1 = __builtin_amdgcn_mfma_f32_32x32x16_bf16(x1, qx, p1, 0, 0, 0); }
}
template <int VB>
__device__ __forceinline__ void pv_tile(f32x16* o, int vb0, bf16x8 pa0, bf16x8 pa1, bf16x8 pa2, bf16x8 pa3) {
#define TRRD(dst, off) asm volatile("ds_read_b64_tr_b16 %0, %1 offset:%2" : "=&v"(dst) : "v"(vb0), "i"(off) : "memory")
#define PV_D0(d0) do { s16x4 l0, l1, l2, l3, h0, h1, h2, h3; constexpr int b_ = OFF_V + VB * SHM_V + v_rd_off(d0, 0, 0); \
        TRRD(l0, b_); TRRD(h0, b_ + 2048); TRRD(l1, b_ + 4096); TRRD(h1, b_ + 6144); TRRD(l2, b_ + 8192); TRRD(h2, b_ + 10240); TRRD(l3, b_ + 12288); TRRD(h3, b_ + 14336); \
        asm volatile("s_waitcnt lgkmcnt(0)" ::: "memory"); SBAR();   \
        o[d0] = __builtin_amdgcn_mfma_f32_32x32x16_bf16(pa0, (bf16x8){l0[0], l0[1], l0[2], l0[3], h0[0], h0[1], h0[2], h0[3]}, o[d0], 0, 0, 0);   \
        o[d0] = __builtin_amdgcn_mfma_f32_32x32x16_bf16(pa1, (bf16x8){l1[0], l1[1], l1[2], l1[3], h1[0], h1[1], h1[2], h1[3]}, o[d0], 0, 0, 0);   \
        o[d0] = __builtin_amdgcn_mfma_f32_32x32x16_bf16(pa2, (bf16x8){l2[0], l2[1], l2[2], l2[3], h2[0], h2[1], h2[2], h2[3]}, o[d0], 0, 0, 0);   \
        o[d0] = __builtin_amdgcn_mfma_f32_32x32x16_bf16(pa3, (bf16x8){l3[0], l3[1], l3[2], l3[3], h3[0], h3[1], h3[2], h3[3]}, o[d0], 0, 0, 0); } while (0)
    PV_D0(0); PV_D0(1); PV_D0(2); PV_D0(3);
#undef PV_D0
#undef TRRD
}
template <int MODE>
__device__ __forceinline__ void attn_block(char* lds, const bf16_t* Qh  , const float* qgain, const float* rot, const bf16_t* Kh, const bf16_t* Vh, const bf16_t* QXh, const bf16_t* KXh,
                                           const unsigned long long* mrow, const bf16_t* gate, bf16_t* Ob, int ocol0, int hoff, int P0,
                                           int jb, int je, float* part, float* pml) {
    int lane; asm volatile("v_mbcnt_lo_u32_b32 %0, -1, 0\n\tv_mbcnt_hi_u32_b32 %0, -1, %0" : "=v"(lane));
    const int wid = __builtin_amdgcn_readfirstlane(threadIdx.x >> 6), tid = wid * 64 + lane, r32 = lane & 31, hi = lane >> 5;
    const int qlo = P0 + wid * QBLK, qm = qlo + r32 - 4 * hi, lastj = qlo / KVBLK;
    float* wsw = (float*)(lds + OFF_W) + wid * 64; float* li_l = wsw; float* al_l = wsw + 32;
    const int vb0 = (int)(uintptr_t)lds + v_rd_base(lane);
    const unsigned ldsb = (unsigned)(uintptr_t)lds;
    bf16x8 qr[8];
    { const bf16_t* qrow = Qh + (size_t)(qlo + r32) * NINP + hi * 8; float qv[8][8]; float ss = 0.f;
#pragma unroll
      for (int d0 = 0; d0 < 8; ++d0) { const u32x4 w = *reinterpret_cast<const u32x4*>(qrow + d0 * 16);
          qv[d0][0] = bf_lo(w.x); qv[d0][1] = bf_hi(w.x); qv[d0][2] = bf_lo(w.y); qv[d0][3] = bf_hi(w.y); qv[d0][4] = bf_lo(w.z); qv[d0][5] = bf_hi(w.z); qv[d0][6] = bf_lo(w.w); qv[d0][7] = bf_hi(w.w);
#pragma unroll
          for (int j = 0; j < 8; ++j) ss = fmaf(qv[d0][j], qv[d0][j], ss); }
      { auto rr = __builtin_amdgcn_permlane32_swap(__float_as_uint(ss), __float_as_uint(ss), false, false); ss = __uint_as_float(rr[0]) + __uint_as_float(rr[1]); }
      const float rstd = 1.f / sqrtf(ss * (1.f / HD) + RMS_EPS);
#pragma unroll
      for (int d0 = 0; d0 < 8; ++d0) { const f32x4 g0 = *(const f32x4*)(qgain + d0 * 16 + hi * 8), g1 = *(const f32x4*)(qgain + d0 * 16 + hi * 8 + 4);
#pragma unroll
          for (int j = 0; j < 4; ++j) { qv[d0][j] *= rstd * g0[j]; qv[d0][4 + j] *= rstd * g1[j]; } }
      if (MODE == 0) { const float* rp = rot + ((size_t)(qlo + r32) * 16 + hi * 8) * 2;
#pragma unroll
          for (int j = 0; j < 8; j += 2) { const f32x4 cs = *(const f32x4*)(rp + 2 * j);
              { const float x1 = qv[0][j], x2 = qv[1][j]; qv[0][j] = x1 * cs[0] - x2 * cs[1]; qv[1][j] = x2 * cs[0] + x1 * cs[1]; }
              { const float x1 = qv[0][j + 1], x2 = qv[1][j + 1]; qv[0][j + 1] = x1 * cs[2] - x2 * cs[3]; qv[1][j + 1] = x2 * cs[2] + x1 * cs[3]; } } }
#pragma unroll
      for (int d0 = 0; d0 < 8; ++d0) { u32x4 w; w.x = cvt_pk_bf16(qv[d0][0], qv[d0][1]); w.y = cvt_pk_bf16(qv[d0][2], qv[d0][3]); w.z = cvt_pk_bf16(qv[d0][4], qv[d0][5]); w.w = cvt_pk_bf16(qv[d0][6], qv[d0][7]);
          qr[d0] = *reinterpret_cast<bf16x8*>(&w); } }
    bf16x8 qx = (bf16x8){0, 0, 0, 0, 0, 0, 0, 0};
    if (MODE == 1 && hi == 0) qx = *reinterpret_cast<const bf16x8*>(QXh + (size_t)(qlo + r32) * 8);
    unsigned koff[2], voff[2];
#pragma unroll
    for (int i = 0; i < 2; ++i) { const int q = tid * 16 + i * 8192;
        { const int row = q >> 8, colB = (q & 255) ^ ((row & 7) << 4); koff[i] = (unsigned)(row * 256 + colB); }
        { const int sb = q >> 9, w = q & 511, kk = (sb >> 2) * 8 + (w >> 6), k = (kk & ~0xC) | ((kk & 4) << 1) | ((kk & 8) >> 1), col = (sb & 3) * 32 + ((w & 63) >> 4) * 8; voff[i] = (unsigned)(k * 256 + col * 2); } }
#define KDMA(k0, bf) do { const bf16_t* kb_ = Kh + (size_t)(k0) * D; _Pragma("unroll") for (int i_ = 0; i_ < 2; ++i_) pg8::glds16_s((const void*)kb_, koff[i_], ldsb + OFF_K + (bf) * SHM_K + wid * 1024 + i_ * 8192); } while (0)
#define VDMA(k0, bf) do { const bf16_t* vb_ = Vh + (size_t)(k0) * D; _Pragma("unroll") for (int i_ = 0; i_ < 2; ++i_) pg8::glds16_s((const void*)vb_, voff[i_], ldsb + OFF_V + (bf) * SHM_V + wid * 1024 + i_ * 8192); } while (0)
    const unsigned mo = (unsigned)(qlo + r32) * 1024u;
#define MLOAD(t_) (*(const unsigned long long*)((const char*)(mrow + (t_)) + mo))
    float m_reg = -1e30f, l_reg = 0.f; f32x16 o[4] = {};
#define RESC(a) do { if (__any((a) < 1.f)) { if (hi == 0) al_l[r32] = (a); asm volatile("s_waitcnt lgkmcnt(0)" ::: "memory");              \
                     for (int d_ = 0; d_ < 4; ++d_) for (int r = 0; r < 16; ++r) o[d_][r] *= al_l[crow(r, hi)]; } } while (0)
    __syncthreads();
    if constexpr (MODE == 0) {
#define ACT(t) ((t) <= lastj)
        unsigned long long mw;
        f32x16 pA0, pA1, pB0, pB1; float mnA = 0.f, mnB = 0.f, alA = 1.f, alB = 1.f; bf16x8 pa0, pa1, pa2, pa3;
        const int NTr = je - jb;
        KDMA(jb * KVBLK, 0); VM_WAIT(); __syncthreads();
        mw = MLOAD(jb); KDMA((jb + 1) * KVBLK, 1); VDMA(jb * KVBLK, 0);
        if (ACT(jb)) { qkt<0, false>(pA0, pA1, lds, r32, hi, qr, qx); mask_bits(pA0, pA1, mw, hi); partialSM(pA0, pA1, m_reg, mnA, alA); }
        VM_WAIT(); __syncthreads();
#define HALF(PX0, PX1, mnX, alX, PY0, PY1, alY, t, KB, VB) do { \
        mw = MLOAD(t); if ((t) + 1 < je) KDMA(((t) + 1) * KVBLK, (KB) ^ 1); VDMA((t) * KVBLK, KB); \
        SBAR(); if (ACT(t)) qkt<KB, false>(PX0, PX1, lds, r32, hi, qr, qx); \
        if (ACT((t) - 1)) finishSM(PY0, PY1, alY, l_reg, pa0, pa1, pa2, pa3); SBAR(); \
        if (ACT((t) - 1)) pv_tile<VB>(o, vb0, pa0, pa1, pa2, pa3); \
        if (ACT(t)) { mask_bits(PX0, PX1, mw, hi); partialSM(PX0, PX1, m_reg, mnX, alX); RESC(alX); } \
        VM_WAIT(); __syncthreads(); } while (0)
#define HALFU(PX0, PX1, mnX, alX, PY0, PY1, alY, t, KB, VB) do { \
        mw = MLOAD(t); if ((t) + 1 < je) KDMA(((t) + 1) * KVBLK, (KB) ^ 1); VDMA((t) * KVBLK, KB); \
        SBAR(); qkt<KB, false>(PX0, PX1, lds, r32, hi, qr, qx); \
        finishSM(PY0, PY1, alY, l_reg, pa0, pa1, pa2, pa3); SBAR(); \
        pv_tile<VB>(o, vb0, pa0, pa1, pa2, pa3); \
        mask_bits(PX0, PX1, mw, hi); partialSM(PX0, PX1, m_reg, mnX, alX); RESC(alX); \
        VM_WAIT(); __syncthreads(); } while (0)
        const int tdiag = P0 / KVBLK; int r = 1;
        for (; r + 1 < NTr && jb + r + 1 <= tdiag; r += 2) {
            HALFU(pB0, pB1, mnB, alB, pA0, pA1, alA, jb + r, 1, 0);
            HALFU(pA0, pA1, mnA, alA, pB0, pB1, alB, jb + r + 1, 0, 1);
        }
        for (; r + 1 < NTr; r += 2) {
            HALF(pB0, pB1, mnB, alB, pA0, pA1, alA, jb + r, 1, 0);
            HALF(pA0, pA1, mnA, alA, pB0, pB1, alB, jb + r + 1, 0, 1);
        }
#undef HALFU
        HALF(pB0, pB1, mnB, alB, pA0, pA1, alA, je - 1, 1, 0);
        if (ACT(je - 1)) { finishSM(pB0, pB1, alB, l_reg, pa0, pa1, pa2, pa3); SBAR(); pv_tile<1>(o, vb0, pa0, pa1, pa2, pa3); }
#undef HALF
#undef ACT
    } else {
        bf16x8 st_x = (bf16x8){0, 0, 0, 0, 0, 0, 0, 0};
        const int xkey = tid >> 1, xhalf = tid & 1; const unsigned xo = (unsigned)xkey * 16u;
#define XLOAD(k0) do { if (tid < 128 && xhalf == 0) st_x = *reinterpret_cast<const bf16x8*>((const char*)(KXh + (size_t)(k0) * 8) + xo); } while (0)
#define XWRITE(bf) do { if (tid < 128) *(bf16x8*)(lds + OFF_X + (bf) * SHM_X + xkey * 32 + xhalf * 16) = st_x; } while (0)
        KDMA(jb * KVBLK, 0); VDMA(jb * KVBLK, 0); XLOAD(jb * KVBLK); VM_WAIT(); XWRITE(0); __syncthreads();
#define STEP(t, BUF) do { \
        if ((t) + 1 < je) { KDMA(((t) + 1) * KVBLK, (BUF) ^ 1); VDMA(((t) + 1) * KVBLK, (BUF) ^ 1); XLOAD(((t) + 1) * KVBLK); } \
        if ((t) <= lastj) { f32x16 p0, p1; float mn, al; bf16x8 pa0, pa1, pa2, pa3; \
            qkt<BUF, true>(p0, p1, lds, r32, hi, qr, qx); \
            if ((t) == lastj) mask_causal(p0, p1, qm - (t) * KVBLK); \
            partialSM(p0, p1, m_reg, mn, al); RESC(al); finishSM(p0, p1, al, l_reg, pa0, pa1, pa2, pa3); SBAR(); \
            pv_tile<BUF>(o, vb0, pa0, pa1, pa2, pa3); } \
        VM_WAIT(); if ((t) + 1 < je) XWRITE((BUF) ^ 1); \
        __syncthreads(); } while (0)
        for (int t = jb; t < je; t += 2) { STEP(t, 0); STEP(t + 1, 1); }
#undef STEP
#undef XLOAD
#undef XWRITE
    }
#undef RESC
#undef KDMA
#undef VDMA
#undef MLOAD
    if (part) {
        if (hi == 0) { pml[(wid * QBLK + r32) * 2] = m_reg; pml[(wid * QBLK + r32) * 2 + 1] = l_reg; }
#pragma unroll
        for (int r = 0; r < 16; ++r)
#pragma unroll
            for (int d0 = 0; d0 < 4; ++d0) part[(size_t)(wid * QBLK + crow(r, hi)) * D + d0 * 32 + r32] = o[d0][r];
        return;
    }
    if (hi == 0) li_l[r32] = l_reg; asm volatile("s_waitcnt lgkmcnt(0)" ::: "memory");
#pragma unroll
    for (int r = 0; r < 16; ++r) { const int orow = qlo + crow(r, hi); const float rl = __builtin_amdgcn_rcpf(li_l[crow(r, hi)]);
#pragma unroll
        for (int d0 = 0; d0 < 4; ++d0) { float v = o[d0][r] * rl; float vn = __shfl_xor(v, 1);
            if ((r32 & 1) == 0) { const int col = d0 * 32 + r32;
                if (MODE == 1) { const unsigned g = *(const unsigned*)(gate + (size_t)orow * 1024 + hoff + col); v *= bf_lo(g); vn *= bf_hi(g); }
                *(unsigned*)(Ob + (size_t)orow * DM + ocol0 + col) = cvt_pk_bf16(v, vn); } } }
}
#undef KSWZ
#undef SBAR
}

__device__ const unsigned short DSA_TAB[48] = {15, 287, 543, 286, 542, 14, 285, 541, 284, 540, 13, 283, 539, 282, 538, 12, 281, 537, 280, 536, 11, 279, 535, 278, 534, 10, 277, 533, 276, 532, 9, 275, 531, 274, 530, 8, 273, 529, 272, 528, 7, 6, 5, 4, 3, 2, 1, 0};

constexpr int MOE_NB_GU = 8 * 224 * 8, MOE_NB_DN = 8 * 32 * 28, MOE_NB = MOE_NB_GU + MOE_NB_DN;
__device__ __forceinline__ void moe_cvt_batch(const float* wg, const float* wu, const float* wd, unsigned char* ws, int b, int wave, int lane) {
    const float* sp; size_t ld; unsigned char* dp;
    if (b < MOE_NB_GU) { const int e = b / 1792, rr = b % 1792, nb = rr >> 3, kb = rr & 7, k0 = 256 * kb + 32 * wave, n0 = 64 * nb; const int tile = n0 >> 8, within = n0 & 255;
        sp = ((within < 128) ? wg : wu) + (size_t)e * DM * DFFE + (size_t)k0 * DFFE + tile * 128 + (within & 127) + lane; ld = DFFE;
        dp = (ws + WS_MWGU) + (size_t)e * 14336 * DM + (size_t)(n0 + lane) * DM + k0; }
    else { const int r = b - MOE_NB_GU; const int e = r / 896, rr = r % 896, nb = rr / 28, kb = rr % 28, k0 = 256 * kb + 32 * wave, n0 = 64 * nb;
        sp = wd + (size_t)e * DFFE * DM + (size_t)k0 * DM + n0 + lane; ld = DM; dp = (ws + WS_MWDN) + (size_t)e * DM * DFFE + (size_t)(n0 + lane) * DFFE + k0; }
    float v[32];
#pragma unroll
    for (int i = 0; i < 32; ++i) v[i] = __builtin_nontemporal_load(sp + (size_t)i * ld) * F8_WSCALE;
#pragma unroll
    for (int c = 0; c < 2; ++c) { u32x4 o; o.x = pk4_fp8(v[16 * c], v[16 * c + 1], v[16 * c + 2], v[16 * c + 3]); o.y = pk4_fp8(v[16 * c + 4], v[16 * c + 5], v[16 * c + 6], v[16 * c + 7]);
        o.z = pk4_fp8(v[16 * c + 8], v[16 * c + 9], v[16 * c + 10], v[16 * c + 11]); o.w = pk4_fp8(v[16 * c + 12], v[16 * c + 13], v[16 * c + 14], v[16 * c + 15]);
        *(u32x4*)(dp + 16 * c) = o; }
}
template <int NPULL>
__device__ __forceinline__ void xcd_barrier_fill(const XcdBarrier& b, volatile LAS unsigned* fs, unsigned* qctr, const float* wg, const float* wu, const float* wd, unsigned char* ws, int tid, int wave, int lane) {
    asm volatile("s_waitcnt vmcnt(0)" ::: "memory");
    __syncthreads();
    if (tid == 0) {
        unsigned* bar = b.bar;
        __builtin_amdgcn_s_waitcnt(0);
        unsigned nloc = b.st[0], nx = b.st[1];
        if (nloc == 0u) { xcd_barrier_complete(bar, b.x, nloc, nx); b.st[0] = nloc; b.st[1] = nx; }
        const unsigned old = xb_add(&bar[XB_XSUB(b.x)], 1u);
        const unsigned gen = old / nloc;
        if (old + 1u == (gen + 1u) * nloc) {
            __builtin_amdgcn_fence(__ATOMIC_RELEASE, "agent");
            asm volatile("s_waitcnt vmcnt(0)" ::: "memory");
            const unsigned og = xb_add(&bar[XB_TOP], 1u);
            const unsigned tg = og / nx;
            if (og + 1u == (tg + 1u) * nx) xb_add(&bar[XB_TOPGEN], 1u);
            else XB_SPIN(xb_ld(&bar[XB_TOPGEN]) == tg, bar);
            __builtin_amdgcn_fence(__ATOMIC_ACQUIRE, "agent");
            xb_add(&bar[XB_XGEN(b.x)], 1u);
            asm volatile("s_waitcnt vmcnt(0)" ::: "memory");
            fs[0] = 1u;
        } else { fs[0] = 0u; fs[1] = gen; }
    }
    __syncthreads();
    if (fs[0] == 0u) {
        const unsigned gen = fs[1];
        for (;;) {
            if (tid == 0) { const unsigned rel = (xb_ld(&b.bar[XB_XGEN(b.x)]) != gen) ? 1u : 0u; fs[2] = rel;
                fs[3] = rel ? 0u : __hip_atomic_fetch_add(qctr, (unsigned)NPULL, __ATOMIC_RELAXED, __HIP_MEMORY_SCOPE_AGENT); }
            __syncthreads();
            const unsigned rel = fs[2], bt = fs[3];
            if (rel) break;
            if (bt >= (unsigned)MOE_NB) {
                if (tid == 0) XB_SPIN(xb_ld(&b.bar[XB_XGEN(b.x)]) == gen, b.bar);
                break; }
#pragma unroll
            for (int q = 0; q < NPULL; ++q) if (bt + q < (unsigned)MOE_NB) moe_cvt_batch(wg, wu, wd, ws, (int)(bt + q), wave, lane);
            __syncthreads();
        }
        if (tid == 0) { __builtin_amdgcn_fence(__ATOMIC_ACQUIRE, "agent"); asm volatile("s_waitcnt vmcnt(0)" ::: "memory"); }
    }
    __syncthreads();
}

struct Args { const float* in[21]; float* out; unsigned char* ws; int ph_lo, ph_hi; };

struct Frame {
    LAS unsigned char* lds;
    int tid, lane, wave, vcu, G;
    unsigned char* ws;
};

__device__ __forceinline__ void tr_item(const float* srcp, size_t ldsrc, bf16_t* dst, size_t ldd, LAS float* scr, int lane) {
    const int c = lane & 31;
#pragma unroll 8
    for (int i = 0; i < 32; ++i) { const int kk = 2 * i + (lane >> 5); scr[kk * 33 + c] = srcp ? srcp[(size_t)kk * ldsrc] : 0.f; }
    LDS_WAIT();
    const int ch = lane & 7;
#pragma unroll
    for (int j = 0; j < 4; ++j) { const int n = (lane >> 3) + 8 * j; const LAS float* s = scr + (8 * ch) * 33 + n;
        u32x4 o; o.x = cvt_pk_bf16(s[0 * 33], s[1 * 33]); o.y = cvt_pk_bf16(s[2 * 33], s[3 * 33]); o.z = cvt_pk_bf16(s[4 * 33], s[5 * 33]); o.w = cvt_pk_bf16(s[6 * 33], s[7 * 33]);
        *(u32x4*)(dst + (size_t)n * ldd + 8 * ch) = o; }
    LDS_WAIT();
}
__device__ __forceinline__ int map_in(int n) {
    if (n < 4096) return n;
    if (n < 7168) return 4176 + (n - 4096);
    if (n < 8192) return 7256 + (n - 7168);
    if (n < 8256) return 4096 + (n - 8192);
    if (n < 8272) return 4160 + (n - 8256);
    if (n < 8280) return 7248 + (n - 8272);
    return -1;
}
__device__ __forceinline__ void rms_row_to_bf16(const float* xrow, const float* gain, bf16_t* orow, int lane) {
    const f32x4* xr = (const f32x4*)xrow + lane; const f32x4* gr = (const f32x4*)gain + lane;
    f32x4 v[8]; float s = 0.f;
#pragma unroll
    for (int j = 0; j < 8; ++j) { v[j] = xr[64 * j]; s += (v[j].x * v[j].x + v[j].y * v[j].y) + (v[j].z * v[j].z + v[j].w * v[j].w); }
    const float rstd = 1.f / sqrtf(wave_sum(s) * (1.f / DM) + RMS_EPS);
    u32x2* o8 = (u32x2*)orow + lane;
#pragma unroll
    for (int j = 0; j < 8; ++j) { const f32x4 g = gr[64 * j]; u32x2 w; w.x = cvt_pk_bf16(v[j].x * rstd * g.x, v[j].y * rstd * g.y); w.y = cvt_pk_bf16(v[j].z * rstd * g.z, v[j].w * rstd * g.w); o8[64 * j] = w; }
}

__global__ void __launch_bounds__(NTHREADS, 2) mega_fwd(Args args) {
    extern __shared__ __attribute__((aligned(16))) unsigned char lds_raw[];
    Frame F;
    F.lds = (LAS unsigned char*)lds_raw;
    F.tid = threadIdx.x; F.lane = F.tid & 63; F.wave = __builtin_amdgcn_readfirstlane(F.tid >> 6);
    F.G = gridDim.x; { const int bx = blockIdx.x; F.vcu = (F.G % 8 == 0) ? (bx % 8) * (F.G / 8) + bx / 8 : bx; }
    F.ws = args.ws;
    unsigned char* ws = args.ws;
    int tid = F.tid, lane = F.lane; const int wave = F.wave;
    const int gw = F.vcu * NWAVES + wave, NGW = F.G * NWAVES;
    volatile LAS unsigned* MISC = (volatile LAS unsigned*)(F.lds + MISC_OFF);
#if MK_FUSED
    for (int u = tid; u < (LDS_BYTES - RING_BYTES) / 4; u += NTHREADS) ((LAS unsigned*)(F.lds + RING_BYTES))[u] = 0u;
    __syncthreads();
    XcdBarrier bar = xcd_barrier_post((unsigned*)(ws + WS_CTL) + CW_BAR, MISC + 8);
    if (tid == 0) { MISC[20] = __hip_atomic_fetch_add((unsigned*)(ws + WS_CTL) + 3200 + 64 * (bar.x & 7u), 1u, __ATOMIC_RELAXED, __HIP_MEMORY_SCOPE_AGENT); MISC[21] = bar.x; }
#define GRID_BAR() xcd_barrier(bar)
#else
    (void)MISC;
#define GRID_BAR() do { } while (0)
#endif
    const int lo = args.ph_lo, hi = args.ph_hi;
    int gcid = (int)blockIdx.x;
#ifndef MK_PHASE_MASK
#define MK_PHASE_MASK 0x3ffff
#endif
#define IN(k) (((MK_PHASE_MASK >> (k)) & 1) && lo <= (k) && (k) < hi)
#define PHASE(k) if (IN(k))
#if MK_FUSED
#define SEAM(k) do { if (IN(k) && IN((k) + 1)) { if ((k) <= 14) xcd_barrier_fill<1>(bar, MISC + 12, (unsigned*)(ws + WS_CTL) + 3072, args.in[18], args.in[19], args.in[20], ws, tid, wave, lane); else xcd_barrier(bar); } } while (0)
#else
#define SEAM(k) do { } while (0)
#endif

#define WIN ((bf16_t*)(ws + WS_WIN))
#define WOUT ((bf16_t*)(ws + WS_WOUT))
#define WGU ((bf16_t*)(ws + WS_WGU))
#define WDN ((bf16_t*)(ws + WS_WDN))
#define WPOOL ((bf16_t*)(ws + WS_WPOOL))
#define MWGU8 ((unsigned char*)(ws + WS_MWGU))
#define MWDN8 ((unsigned char*)(ws + WS_MWDN))
#define SCORES ((float*)(ws + WS_BIG1))
#define ACT ((bf16_t*)(ws + WS_BIG1))
#define ACTM8 ((unsigned char*)(ws + WS_BIG1))
#define PROJ ((bf16_t*)(ws + WS_BIG2))
#define YM ((bf16_t*)(ws + WS_BIG2))
#define YMP ((float*)(ws + WS_YMP))
#define QA ((bf16_t*)(ws + WS_ATT))
#define KA (QA + (size_t)NH * S * HD)
#define VA (QA + (size_t)2 * NH * S * HD)
#define QB (QA + (size_t)3 * NH * S * HD)
#define KB (QA + (size_t)4 * NH * S * HD)
#define VB (QA + (size_t)5 * NH * S * HD)
#define GBG (QA + (size_t)6 * NH * S * HD)
#define QI (GBG + (size_t)S * 1024)
#define HS8 ((unsigned char*)(ws + WS_ATT))
#define MASK ((unsigned long long*)(ws + WS_MASK))
#define OB ((bf16_t*)(ws + WS_O))
#define POOLED ((bf16_t*)(ws + WS_O))
#define HB ((bf16_t*)(ws + WS_H))
#define X1 ((float*)(ws + WS_X1))
#define X3 ((float*)(ws + WS_X1))
#define X2 ((float*)(ws + WS_X2))
#define WI ((float*)(ws + WS_WI))
#define LOGF ((float*)(ws + WS_LOGF))
#define CC ((float*)(ws + WS_CC))
#define TOKE ((unsigned*)(ws + WS_TOKE))
#define TOKG ((f32x2*)(ws + WS_TOKG))
#define RSTD3 ((float*)(ws + WS_RSTD3))
#define SLOT ((u32x2*)(ws + WS_SLOT))
#define CNT ((unsigned*)(ws + WS_CNT))
#define TEXP ((int*)(ws + WS_TEXP))
#define KI ((bf16_t*)(ws + WS_KI))
#define QX ((bf16_t*)(ws + WS_QX))
#define NQB ((float*)(ws + WS_NQB))
#define NKB ((float*)(ws + WS_NKB))
#define JLO ((int*)(ws + WS_JLO))
#define ROT ((float*)(ws + WS_ROT))
#define QLIN ((bf16_t*)(ws + WS_QLIN))
#define PART ((float*)(ws + WS_PART))
#define PML ((float*)(ws + WS_PART + 32 * MiB))
#define KX ((bf16_t*)(ws + WS_KX))
#define x_in (args.in[0])

    PHASE(0) {
        LAS unsigned char* tscr = F.lds + wave * 8192;
        constexpr int I_IN = 132 * 32, I_OUT = 32 * 32, I_GU = 176 * 32, I_DN = 32 * 88, I_PL = 4 * 8 * 8;
        constexpr int NITEMS = I_IN + I_OUT + I_GU + I_DN + I_PL;
        for (int it = gw; it < NITEMS; it += NGW) {
            int r = it; const float* sp; size_t ld, dpitch; bf16_t* dp0;
            if (r < I_IN) { const int kb = r / 132, nb = r % 132, k0 = 64 * kb, n0 = 64 * nb; const int scn = map_in(n0 + lane);
                sp = scn >= 0 ? args.in[2] + (size_t)k0 * 8280 + scn : nullptr; ld = 8280; dp0 = WIN + (size_t)n0 * DM + k0; dpitch = DM * 2; }
            else if ((r -= I_IN) < I_OUT) { const int kb = r / 32, nb = r % 32, k0 = 64 * kb, n0 = 64 * nb;
                sp = args.in[8] + (size_t)k0 * DM + n0 + lane; ld = DM; dp0 = WOUT + (size_t)n0 * DM + k0; dpitch = DM * 2; }
            else if ((r -= I_OUT) < I_GU) { const int kb = r / 176, nb = r % 176, k0 = 64 * kb, n0 = 64 * nb; const int tile = n0 >> 8, within = n0 & 255;
                sp = ((within < 128) ? args.in[10] : args.in[11]) + (size_t)k0 * DFF + tile * 128 + (within & 127) + lane; ld = DFF; dp0 = WGU + (size_t)n0 * DM + k0; dpitch = DM * 2; }
            else if ((r -= I_GU) < I_DN) { const int kb = r / 32, nb = r % 32, k0 = 64 * kb, n0 = 64 * nb;
                sp = args.in[12] + (size_t)k0 * DM + n0 + lane; ld = DM; dp0 = WDN + (size_t)n0 * DFF + k0; dpitch = DFF * 2; }
            else { r -= I_DN; const int g = r / 64, rr = r % 64, kb = rr / 8, nb = rr % 8, k0 = 64 * kb, n0 = 64 * nb;
                sp = args.in[14] + (size_t)g * 512 * 512 + (size_t)k0 * 512 + n0 + lane; ld = 512; dp0 = WPOOL + (size_t)g * 512 * 512 + (size_t)n0 * 512 + k0; dpitch = 512 * 2; }
            float v[64];
#pragma unroll
            for (int i = 0; i < 64; ++i) v[i] = sp ? __builtin_nontemporal_load(sp + (size_t)i * ld) : 0.f;
#pragma unroll
            for (int c8 = 0; c8 < 8; ++c8) { u32x4 o; o.x = cvt_pk_bf16(v[8 * c8], v[8 * c8 + 1]); o.y = cvt_pk_bf16(v[8 * c8 + 2], v[8 * c8 + 3]); o.z = cvt_pk_bf16(v[8 * c8 + 4], v[8 * c8 + 5]); o.w = cvt_pk_bf16(v[8 * c8 + 6], v[8 * c8 + 7]);
                *(LAS u32x4*)(tscr + lane * 128 + ((c8 ^ (lane & 7)) << 4)) = o; }
            LDS_WAIT();
#pragma unroll
            for (int i = 0; i < 8; ++i) { const int row = 8 * i + (lane >> 3), ch = lane & 7;
                *(u32x4*)((char*)dp0 + (size_t)row * dpitch + ch * 16) = *(const LAS u32x4*)(tscr + row * 128 + ((ch ^ (row & 7)) << 4)); }
            LDS_WAIT();
        }
        for (int e_ = gw * 64 + lane; e_ < S * 16; e_ += NGW * 64) {
            const int m = e_ >> 4, i = e_ & 15; const float fm = powf(500000.0f, -(float)i * (1.0f / 16.0f)), am = (float)m * fm; *(f32x2*)(ROT + (size_t)e_ * 2) = (f32x2){cosf(am), sinf(am)}; }
        for (int m = gw; m < S; m += NGW) rms_row_to_bf16(x_in + (size_t)m * DM, args.in[1], HB + (size_t)m * DM, lane);
    }
    SEAM(0);
#if MK_FUSED
    if (IN(0) && IN(1)) {
        if (tid == 0) { unsigned* bw = (unsigned*)(ws + WS_CTL) + CW_BAR; bool ok = (F.G % 8) == 0 && MISC[21] < 8u;
            for (int j = 0; j < 8; ++j) ok = ok && (xb_ld(&bw[XB_XCNT(j)]) == (unsigned)(F.G / 8));
            MISC[22] = ok ? (MISC[20] * 8u + MISC[21]) : (unsigned)blockIdx.x; }
        __syncthreads();
        gcid = __builtin_amdgcn_readfirstlane((int)MISC[22]);
    }
#endif

    PHASE(1) {
        pg8::SchedPlain Sd{(const char*)HB, (const char*)WIN, S / 256, NINP / 256, F.G, gcid, (size_t)256 * DM * 2};
        pg8::EpiInProj E{PROJ, NINP, VA, VB, GBG};
        pg8::gemm_phase(F.lds, DM * 2, DM * 2 / 128, Sd, E);
    }
    SEAM(1);

    PHASE(2) {
        const float* qn_a = args.in[4]; const float* kn_a = args.in[5]; const float* qn_b = args.in[6]; const float* kn_b = args.in[7]; const float* bfor = args.in[3];
        const float ga0 = qn_a[2 * lane], ga1 = qn_a[2 * lane + 1], gk0 = kn_a[2 * lane], gk1 = kn_a[2 * lane + 1];
        const float gb0 = qn_b[2 * lane], gb1 = qn_b[2 * lane + 1], gkb0 = kn_b[2 * lane], gkb1 = kn_b[2 * lane + 1];
        const int TPW = S / NGW;
        unsigned nx[25]; bf16_t nwi, nfb;
#define P2_LOAD(tt) do { const unsigned* pr_ = (const unsigned*)(PROJ + (size_t)(tt) * NINP) + lane; \
            _Pragma("unroll") for (int j_ = 0; j_ < 8; ++j_) { nx[j_] = pr_[64 * (8 + j_)]; nx[8 + j_] = pr_[64 * (24 + j_)]; nx[16 + j_] = pr_[64 * (40 + j_)]; } \
            nx[24] = pr_[64 * 64]; nwi = PROJ[(size_t)(tt) * NINP + C_WI + (lane & 15)]; nfb = PROJ[(size_t)(tt) * NINP + C_FB + (lane & 7)]; } while (0)
        const int t0_ = gw * TPW;
        P2_LOAD(t0_);
        for (int t = t0_; t < t0_ + TPW; ++t) {
            unsigned pv[65];
#pragma unroll
            for (int j = 0; j < 8; ++j) { pv[8 + j] = nx[j]; pv[24 + j] = nx[8 + j]; pv[40 + j] = nx[16 + j]; }
            pv[64] = nx[24]; const bf16_t wi_raw = nwi, fb_raw = nfb;
            const int i0 = 2 * (lane & 7), j0 = 2 * (lane & 3);
            const f32x4 cm = *(const f32x4*)(ROT + ((size_t)t * 16 + i0) * 2);
            const f32x2 ci0 = *(const f32x2*)(ROT + ((size_t)t * 16 + 2 * j0) * 2), ci1 = *(const f32x2*)(ROT + ((size_t)t * 16 + 2 * j0 + 2) * 2);
            const float c0 = cm[0], s0 = cm[1], c1 = cm[2], s1 = cm[3], ic0 = ci0[0], is0 = ci0[1], ic1 = ci1[0], is1 = ci1[1];
            if (t + 1 < t0_ + TPW) P2_LOAD(t + 1);
            const float wsc = bf1(wi_raw) * (1.0f / 32.0f); float qla = 0.f, qlb = 0.f;
#pragma unroll
            for (int h = 0; h < NH; ++h) {
#pragma unroll
                for (int which = 1; which < 2; ++which) {
                    const unsigned w = pv[(which ? 8 : 0) + h];
                    float a = bf_lo(w), b = bf_hi(w);
                    const float r = 1.f / sqrtf(wave_sum(a * a + b * b) * (1.f / HD) + RMS_EPS);
                    a *= r * (which ? gk0 : ga0); b *= r * (which ? gk1 : ga1);
                    const float pa = __shfl_xor(a, 8), pb = __shfl_xor(b, 8);
                    if (lane < 8) { a = a * c0 - pa * s0; b = b * c1 - pb * s1; }
                    else if (lane < 16) { a = a * c0 + pa * s0; b = b * c1 + pb * s1; }
                    ((unsigned*)((which ? KA : QA) + ((size_t)h * S + t) * HD))[lane] = cvt_pk_bf16(a, b);
                }
#pragma unroll
                for (int which = 1; which < 2; ++which) {
                    const unsigned w = pv[(which ? 40 : 32) + h];
                    float a = bf_lo(w), b = bf_hi(w);
                    const float r = 1.f / sqrtf(wave_sum(a * a + b * b) * (1.f / HD) + RMS_EPS);
                    a *= r * (which ? gkb0 : gb0); b *= r * (which ? gkb1 : gb1);
                    { const float n2 = wave_sum(a * a + b * b); if (lane == 0) (which ? NKB : NQB)[(size_t)h * S + t] = n2; }
                    ((unsigned*)((which ? KB : QB) + ((size_t)h * S + t) * HD))[lane] = cvt_pk_bf16(a, b);
                }
                { const unsigned w = pv[24 + h]; float a = bf_lo(w), b = bf_hi(w);
                  const float pa = __shfl_xor(a, 4), pb = __shfl_xor(b, 4); const int l5 = lane & 31;
                  if (l5 < 4) { a = a * ic0 - pa * is0; b = b * ic1 - pb * is1; }
                  else if (l5 < 8) { a = a * ic0 + pa * is0; b = b * ic1 + pb * is1; }
                  const unsigned pk = cvt_pk_bf16(a, b); ((unsigned*)(QI + (size_t)t * 1024 + h * HD))[lane] = pk;
                  const float wv = __shfl(wsc, 2 * h + (lane >> 5)); qla = fmaf(wv, bf_lo(pk), qla); qlb = fmaf(wv, bf_hi(pk), qlb); }
            }
            { const float ta = qla + __shfl_xor(qla, 32), tb = qlb + __shfl_xor(qlb, 32);
              if (lane < 32) ((unsigned*)(QLIN + (size_t)t * IDD))[lane] = cvt_pk_bf16(ta, tb); }
            { const unsigned w = pv[64]; float a = bf_lo(w), b = bf_hi(w);
              const float pa = __shfl_xor(a, 4), pb = __shfl_xor(b, 4); const int l5 = lane & 31;
              if (l5 < 4) { a = a * ic0 - pa * is0; b = b * ic1 - pb * is1; }
              else if (l5 < 8) { a = a * ic0 + pa * is0; b = b * ic1 + pb * is1; }
              if (lane < 32) ((unsigned*)(KI + (size_t)t * IDD))[lane] = cvt_pk_bf16(a, b); }
            if (lane < 16) WI[(size_t)t * 16 + lane] = wsc;
            if (lane < 8) { const float z = bf1(fb_raw) + bfor[lane]; LOGF[(size_t)lane * S + t] = fminf(z, 0.f) - log1pf(__expf(-fabsf(z))); }
        }
    }
#undef P2_LOAD
    SEAM(2);

    PHASE(3) {
        if ((int)blockIdx.x >= F.G - NH) {
            const int h = (int)blockIdx.x - (F.G - NH); LAS double* sd = (LAS double*)F.lds;
            double loc[16]; double s = 0.0;
#pragma unroll
            for (int i = 0; i < 16; ++i) { s += (double)LOGF[(size_t)h * S + tid * 16 + i]; loc[i] = s; }
            sd[tid] = s; __syncthreads();
            if (tid == 0) { double run = 0.0; for (int i = 0; i < NTHREADS; ++i) { const double v = sd[i]; sd[i] = run; run += v; } }
            __syncthreads();
            const double base = sd[tid];
#pragma unroll
            for (int i = 0; i < 16; ++i) CC[(size_t)h * S + tid * 16 + i] = (float)(base + loc[i]);
            LAS float* cend = (LAS float*)(F.lds + 8192); LAS float* cp0 = cend + 128; LAS float* redm = cp0 + 32;
            { float mq = 0.f, mk = 0.f;
              { const float* gq = args.in[6]; for (int i = 0; i < HD; ++i) mq = fmaxf(mq, gq[i] * gq[i]); mq *= (float)HD; }
#pragma unroll
              for (int i = 0; i < 16; ++i) { const int e_ = tid * 16 + i; mk = fmaxf(mk, NKB[(size_t)h * S + e_]);
                  const float cv = (float)(base + loc[i]); if ((e_ & 63) == 63) cend[e_ >> 6] = cv; if ((e_ & 255) == 0) cp0[e_ >> 8] = cv; }
#pragma unroll
              for (int o = 1; o < 64; o <<= 1) { mq = fmaxf(mq, __shfl_xor(mq, o)); mk = fmaxf(mk, __shfl_xor(mk, o)); }
              if (lane == 0) { redm[wave] = mq; redm[8 + wave] = mk; } }
            __syncthreads();
            if (tid < 32) { float mq = redm[0], mk = redm[8];
#pragma unroll
                for (int i = 1; i < NWAVES; ++i) { mq = fmaxf(mq, redm[i]); mk = fmaxf(mk, redm[8 + i]); }
                const float T = 2.f * (ATT_SCALE * sqrtf(mq * mk) * 1.02f) + 27.f, c0 = cp0[tid];
                int j = 0; while (j < 4 * tid && c0 - cend[j] < -T) ++j;
                JLO[h * 32 + tid] = j & ~1; }
#pragma unroll
            for (int i = 0; i < 16; ++i) { const double cs = (base + loc[i]) * 11.313708498984761;
                const unsigned b1 = cvt_pk_bf16((float)cs, 0.f) & 0xffffu; const double r1 = cs - (double)__uint_as_float(b1 << 16);
                const unsigned b2 = cvt_pk_bf16((float)r1, 0.f) & 0xffffu; const double r2 = r1 - (double)__uint_as_float(b2 << 16);
                const unsigned b3 = cvt_pk_bf16((float)r2, 0.f) & 0xffffu; const unsigned one = 0x3f80u;
                const size_t e = ((size_t)h * S + tid * 16 + i) * 8;
                *(u32x4*)(QX + e) = (u32x4){b1 | (b2 << 16), b3 | (one << 16), one | (one << 16), 0u};
                *(u32x4*)(KX + e) = (u32x4){one | (one << 16), one | ((b1 ^ 0x8000u) << 16), (b2 ^ 0x8000u) | ((b3 ^ 0x8000u) << 16), 0u}; }
            __syncthreads();
        }
        const int r32 = lane & 31, hi5 = lane >> 5;
        constexpr int NITEM = 1152;
#define IDX_DECODE(it_, q0_, seg_, nadm_) do { int g_ = 0; while (32 * (g_ + 1) * (g_ + 2) / 2 <= (it_)) ++g_; \
            const int rem_ = (it_) - 32 * g_ * (g_ + 1) / 2, nseg_ = g_ + 1; q0_ = (g_ * 32 + rem_ / nseg_) * 32; seg_ = rem_ % nseg_; nadm_ = (q0_ / 64 + 1) * 64; } while (0)
#define IDX_STAGE_Q(b_, q0_) do { const bf16_t* qsrc_ = QI + (size_t)(q0_) * 1024; _Pragma("unroll") for (int i_ = 0; i_ < 8; ++i_) \
            pg8::glds16_s((const void*)qsrc_, (unsigned)((lane & 31) * 2048 + (2 * wave + 16 * i_ + (lane >> 5)) * 16), ldsb3 + (unsigned)(b_) * 65536u + (unsigned)(2 * wave + 16 * i_) * 512u); } while (0)
        const unsigned ldsb3 = (unsigned)(uintptr_t)F.lds;
        LAS float* const Wsb = (LAS float*)(F.lds + RING_BYTES + 1024);
        int it = blockIdx.x, buf = 0, q0 = 0, seg = 0, nadm = 0;
        __syncthreads();
        if (it < NITEM) { IDX_DECODE(it, q0, seg, nadm); IDX_STAGE_Q(0, q0); Wsb[(tid >> 5) * 32 + (tid & 31)] = WI[(size_t)(q0 + (tid & 31)) * 16 + (tid >> 5)]; }
        for (; it < NITEM; it += F.G) {
            const int kb0 = seg * 1024 + wave * 128; const bool act = kb0 < nadm;
            bf16x8 kf[4][4], qlf[4];
            if (act) {
#pragma unroll
                for (int j = 0; j < 4; ++j)
#pragma unroll
                    for (int ks = 0; ks < 4; ++ks) kf[j][ks] = *(const bf16x8*)(KI + (size_t)(kb0 + 32 * j + r32) * IDD + ks * 16 + hi5 * 8);
#pragma unroll
                for (int ks = 0; ks < 4; ++ks) qlf[ks] = *(const bf16x8*)(QLIN + (size_t)(q0 + r32) * IDD + ks * 16 + hi5 * 8);
            }
            VM_WAIT();
            __syncthreads();
            const int nit = it + F.G; const bool has_next = nit < NITEM; int nq0 = 0, nseg2 = 0, nnadm = 0; float wn = 0.f;
            if (has_next) { IDX_DECODE(nit, nq0, nseg2, nnadm); IDX_STAGE_Q(buf ^ 1, nq0); wn = WI[(size_t)(nq0 + (tid & 31)) * 16 + (tid >> 5)]; }
            if (act) {
                LAS unsigned char* Qs = F.lds + buf * 65536; LAS float* Ws = Wsb + buf * 512;
                f32x16 sacc[4];
#pragma unroll
                for (int j = 0; j < 4; ++j) sacc[j] = f32x16{};
#pragma unroll 2
                for (int h = 0; h < NIH; ++h) {
                    bf16x8 qf[4];
#pragma unroll
                    for (int ks = 0; ks < 4; ++ks) qf[ks] = *(const LAS bf16x8*)(Qs + (((h * 4 + ks) * 2 + hi5) * 32 + r32) * 16);
                    const float wh = Ws[h * 32 + r32];
#pragma unroll
                    for (int j = 0; j < 4; ++j) { f32x16 c = f32x16{};
#pragma unroll
                        for (int ks = 0; ks < 4; ++ks) c = __builtin_amdgcn_mfma_f32_32x32x16_bf16(kf[j][ks], qf[ks], c, 0, 0, 0);
                        float s0 = fmaf(wh, __builtin_fabsf(c[0]), sacc[j][0]); sacc[j][0] = s0;
#pragma unroll
                        for (int r = 1; r < 16; ++r) { float a_ = sacc[j][r]; asm("v_fma_f32 %0, %1, |%2|, %0" : "+v"(a_) : "v"(wh), "v"(c[r]), "v"(s0)); sacc[j][r] = a_; } }
                }
#pragma unroll
                for (int j = 0; j < 4; ++j) { f32x16 c = f32x16{};
#pragma unroll
                    for (int ks = 0; ks < 4; ++ks) c = __builtin_amdgcn_mfma_f32_32x32x16_bf16(kf[j][ks], qlf[ks], c, 0, 0, 0);
#pragma unroll
                    for (int r = 0; r < 16; ++r) sacc[j][r] = 0.5f * (sacc[j][r] + c[r]); }
                float* srow = SCORES + (size_t)(q0 + r32) * S;
#pragma unroll
                for (int j = 0; j < 4; ++j) if (kb0 + 32 * j < nadm) {
#pragma unroll
                    for (int rg = 0; rg < 4; ++rg) *(f32x4*)(srow + kb0 + 32 * j + 8 * rg + 4 * hi5) = (f32x4){sacc[j][4 * rg], sacc[j][4 * rg + 1], sacc[j][4 * rg + 2], sacc[j][4 * rg + 3]}; }
            }
            if (has_next) { Wsb[(buf ^ 1) * 512 + (tid >> 5) * 32 + (tid & 31)] = wn; q0 = nq0; seg = nseg2; nadm = nnadm; buf ^= 1; }
        }
        VM_WAIT(); __syncthreads();
#undef IDX_DECODE
#undef IDX_STAGE_Q
    }
    SEAM(3);

    PHASE(4) {
        constexpr int P4_CAP = 24, P4_WAVE_BYTES = 8448 + (P4_CAP + 1) * 256;
        LAS unsigned* hist = (LAS unsigned*)(F.lds + wave * P4_WAVE_BYTES);
        LAS unsigned* clist = hist + 2112;
        auto scan_hist = [&](unsigned kk, unsigned& bin_o, unsigned& cab_o, unsigned& cbin_o) __attribute__((always_inline)) {
            unsigned c32 = 0u;
#pragma unroll
            for (int j = 0; j < 32; ++j) c32 += hist[33 * lane + j];
            unsigned incl = c32;
#pragma unroll
            for (int o = 1; o < 64; o <<= 1) { const unsigned v = __shfl_down(incl, o); if (lane + o < 64) incl += v; }
            const unsigned above = incl - c32;
            const unsigned long long bal = __ballot((above < kk) && (kk <= incl));
            const int srcl = bal ? (int)__ffsll((long long)bal) - 1 : 0;
            const unsigned a0 = __shfl(above, srcl);
            const unsigned hj = (lane < 32) ? hist[33 * srcl + lane] : 0u;
            unsigned si = hj;
#pragma unroll
            for (int o = 1; o < 32; o <<= 1) { const unsigned v = __shfl_down(si, o); if (lane + o < 64) si += v; }
            const unsigned ab2 = a0 + si - hj;
            const unsigned long long bal2 = __ballot((lane < 32) && (ab2 < kk) && (kk <= ab2 + hj));
            const int j2 = bal2 ? (int)__ffsll((long long)bal2) - 1 : 0;
            bin_o = 32u * (unsigned)srcl + (unsigned)j2; cab_o = __shfl(ab2, j2); cbin_o = __shfl(hj, j2);
        };
        auto zero_hist = [&]() __attribute__((always_inline)) {
#pragma unroll
            for (int q = 0; q < 9; ++q) if (lane + 64 * q < 528) ((LAS u32x4*)hist)[lane + 64 * q] = (u32x4){0u, 0u, 0u, 0u};
            LDS_WAIT();
        };
        for (int t = gw; t < S; t += NGW) {
            const int n = (t / 64 + 1) * 64, nw = n / 64;
            unsigned long long w0 = 0ull, w1 = 0ull;
            if (n <= TOPK) { w0 = (lane < nw) ? ~0ull : 0ull; }
            else {
                const float* srow = SCORES + (size_t)t * S + lane;
                unsigned key[128];
#pragma unroll
                for (int i = 0; i < 128; ++i) key[i] = __float_as_uint(srow[64 * ((i < nw) ? i : 0)]);
#pragma unroll
                for (int i = 0; i < 128; ++i) { const unsigned u = key[i]; key[i] = (i < nw) ? ((u & 0x80000000u) ? ~u : (u | 0x80000000u)) : 0u; }
                unsigned prefix, kk = TOPK, bin, cab, cbin;
                zero_hist();
#pragma unroll
                for (int c = 0; c < 8; ++c) {
                    if (16 * c < nw) {
#pragma unroll
                        for (int j = 0; j < 16; ++j) { const unsigned d = key[16 * c + j] >> 21;
                            __hip_atomic_fetch_add(hist + (d + (d >> 5)), 1u, __ATOMIC_RELAXED, __HIP_MEMORY_SCOPE_WORKGROUP); }
                    }
                }
                LDS_WAIT();
                scan_hist(kk, bin, cab, cbin);
                kk -= cab; prefix = bin << 21;
                LDS_WAIT();
                unsigned cnt = 0u;
#pragma unroll
                for (int c = 0; c < 8; ++c) {
                    if (16 * c < nw) {
#pragma unroll
                        for (int j = 0; j < 16; ++j) { const unsigned k_ = key[16 * c + j];
                            clist[(cnt < (unsigned)P4_CAP ? cnt : (unsigned)P4_CAP) * 64u + lane] = k_;
                            cnt += ((k_ >> 21) == bin) ? 1u : 0u; }
                    }
                }
                unsigned mx = cnt;
#pragma unroll
                for (int o = 32; o > 0; o >>= 1) { const unsigned v = __shfl_xor(mx, o); mx = (v > mx) ? v : mx; }
                const int maxc = __builtin_amdgcn_readfirstlane((int)mx);
                LDS_WAIT();
#pragma unroll 1
                for (int pass = 1; pass < 3; ++pass) {
                    const int shift = (pass == 1) ? 10 : 0;
                    const unsigned dmask = (pass == 2) ? 1023u : 2047u;
                    const unsigned pmask = (pass == 1) ? 0xffe00000u : 0xfffffc00u;
                    zero_hist();
                    if (maxc <= P4_CAP) {
#pragma unroll 1
                        for (int s = 0; s < maxc; ++s) {
                            if ((unsigned)s < cnt) { const unsigned k_ = clist[s * 64 + lane];
                                if (((k_ ^ prefix) & pmask) == 0u) { const unsigned d = (k_ >> shift) & dmask;
                                    __hip_atomic_fetch_add(hist + (d + (d >> 5)), 1u, __ATOMIC_RELAXED, __HIP_MEMORY_SCOPE_WORKGROUP); } }
                        }
                    } else {
#pragma unroll
                        for (int c = 0; c < 8; ++c) {
                            if (16 * c < nw) {
#pragma unroll
                                for (int j = 0; j < 16; ++j) { const unsigned k_ = key[16 * c + j];
                                    if (((k_ ^ prefix) & pmask) == 0u) { const unsigned d = (k_ >> shift) & dmask;
                                        __hip_atomic_fetch_add(hist + (d + (d >> 5)), 1u, __ATOMIC_RELAXED, __HIP_MEMORY_SCOPE_WORKGROUP); } }
                            }
                        }
                    }
                    LDS_WAIT();
                    scan_hist(kk, bin, cab, cbin);
                    kk -= cab; prefix |= bin << shift;
                    LDS_WAIT();
                    if (kk == cbin) break;
                }
                int w0l = 0, w0h = 0, w1l = 0, w1h = 0;
#pragma unroll
                for (int i = 0; i < 64; ++i) { const unsigned long long b0 = __ballot(key[i] >= prefix), b1 = __ballot(key[64 + i] >= prefix);
                    w0l = wl_i32((int)(unsigned)b0, i, w0l); w0h = wl_i32((int)(unsigned)(b0 >> 32), i, w0h);
                    w1l = wl_i32((int)(unsigned)b1, i, w1l); w1h = wl_i32((int)(unsigned)(b1 >> 32), i, w1h); }
                w0 = ((unsigned long long)(unsigned)w0h << 32) | (unsigned)w0l; w1 = ((unsigned long long)(unsigned)w1h << 32) | (unsigned)w1l;
            }
            MASK[(size_t)t * 128 + lane] = w0; MASK[(size_t)t * 128 + 64 + lane] = w1;
        }
    }
    SEAM(4);

    PHASE(5) {
        LAS unsigned* qsl = (LAS unsigned*)(F.lds + fa::OFF_W + NWAVES * 64 * 4);
        unsigned* const qctr = (unsigned*)(ws + WS_CTL) + 2048;
        const int myx = (int)(xb_xcc_id() & 7u);
        if (MK_ATT_MODES & 1) for (int qi = 0; qi < NH; ++qi) { const int h = (myx + qi) & 7; const size_t ho = (size_t)h * S * HD;
            for (;;) {
                __syncthreads();
                { int l0; asm volatile("v_mbcnt_lo_u32_b32 %0, -1, 0\n\tv_mbcnt_hi_u32_b32 %0, -1, %0" : "=v"(l0)); if (wave == 0 && l0 == 0) qsl[0] = __hip_atomic_fetch_add(qctr + 64 * h, 1u, __ATOMIC_RELAXED, __HIP_MEMORY_SCOPE_AGENT); }
                __syncthreads();
                const unsigned idx = qsl[0]; if (idx >= 48u) break;
                const int ent = DSA_TAB[idx], qb = ent & 255, prt = ent >> 8, NTq = 4 * (qb + 1);
                const int jb = (prt == 2) ? NTq / 2 : 0, je = (prt == 1) ? NTq / 2 : NTq;
                const int slot = (h * 16 + (qb - 16)) * 2 + (prt - 1);
                fa::attn_block<0>((char*)lds_raw, PROJ + C_QA + h * HD, args.in[4], ROT, KA + ho, VA + ho, nullptr, nullptr, MASK, nullptr, OB, h * HD, 0, qb * 256, jb, je,
                                  prt ? PART + (size_t)slot * 256 * HD : nullptr, prt ? PML + (size_t)slot * 512 : nullptr);
            } }
        if (MK_ATT_MODES & 2) for (int qi = 0; qi < NH; ++qi) { const int h = (myx + qi) & 7; const size_t ho = (size_t)h * S * HD;
            for (;;) {
                __syncthreads();
                { int l0; asm volatile("v_mbcnt_lo_u32_b32 %0, -1, 0\n\tv_mbcnt_hi_u32_b32 %0, -1, %0" : "=v"(l0)); if (wave == 0 && l0 == 0) qsl[0] = __hip_atomic_fetch_add(qctr + 512 + 64 * h, 1u, __ATOMIC_RELAXED, __HIP_MEMORY_SCOPE_AGENT); }
                __syncthreads();
                const unsigned idx = qsl[0]; if (idx >= 32u) break;
                const int qb = 31 - (int)idx;
                const int jb = __builtin_amdgcn_readfirstlane(JLO[h * 32 + qb]);
                fa::attn_block<1>((char*)lds_raw, PROJ + C_QB + h * HD, args.in[6], nullptr, KB + ho, VB + ho, QX + (size_t)h * S * 8, KX + (size_t)h * S * 8, nullptr, GBG, OB, 1024 + h * HD, h * HD, qb * 256, jb, 4 * (qb + 1), nullptr, nullptr);
            } }
        __syncthreads();
    }
    { int l2; asm volatile("v_mbcnt_lo_u32_b32 %0, -1, 0\n\tv_mbcnt_hi_u32_b32 %0, -1, %0" : "=v"(l2)); lane = l2; tid = wave * 64 + l2; }
    SEAM(5);

    PHASE(6) {
        for (int u = F.vcu; u < 256; u += F.G) {
            const int blk = u >> 1, h = blk >> 4, qb = 16 + (blk & 15), row = (u & 1) * 128 + (tid >> 2), cq = (tid & 3) * 32;
            const float* p1 = PART + (size_t)(blk * 2) * 256 * HD + (size_t)row * HD + cq; const float* p2 = p1 + (size_t)256 * HD;
            const float* ml1 = PML + (size_t)(blk * 2) * 512 + row * 2; const float* ml2 = ml1 + 512;
            const float m1 = ml1[0], l1 = ml1[1], m2 = ml2[0], l2 = ml2[1], m = fmaxf(m1, m2);
            constexpr float C2 = 1.4426950408889634f * ATT_SCALE;
            const float a1 = __builtin_amdgcn_exp2f((m1 - m) * C2), a2 = __builtin_amdgcn_exp2f((m2 - m) * C2), rl = 1.f / (l1 * a1 + l2 * a2), w1 = a1 * rl, w2 = a2 * rl;
            bf16_t* op = OB + (size_t)(qb * 256 + row) * DM + h * HD + cq;
#pragma unroll
            for (int c = 0; c < 4; ++c) { const f32x4 x0 = *(const f32x4*)(p1 + 8 * c) * w1 + *(const f32x4*)(p2 + 8 * c) * w2, x1 = *(const f32x4*)(p1 + 8 * c + 4) * w1 + *(const f32x4*)(p2 + 8 * c + 4) * w2;
                u32x4 w; w.x = cvt_pk_bf16(x0[0], x0[1]); w.y = cvt_pk_bf16(x0[2], x0[3]); w.z = cvt_pk_bf16(x1[0], x1[1]); w.w = cvt_pk_bf16(x1[2], x1[3]);
                *(u32x4*)(op + 8 * c) = w; }
        }
    }
    SEAM(6);

    PHASE(7) {
        pg8::SchedPlain Sd{(const char*)OB, (const char*)WOUT, S / 256, DM / 256, F.G, gcid, (size_t)256 * DM * 2};
        pg8::EpiResid E{x_in, X1, DM, nullptr, 1.f};
        pg8::gemm_phase(F.lds, DM * 2, DM * 2 / 128, Sd, E);
    }
    SEAM(7);

    PHASE(8) { for (int m = gw; m < S; m += NGW) rms_row_to_bf16(X1 + (size_t)m * DM, args.in[9], HB + (size_t)m * DM, lane); }
    SEAM(8);

    PHASE(9) {
        pg8::SchedPlain Sd{(const char*)HB, (const char*)WGU, S / 256, 2 * DFF / 256, F.G, gcid, (size_t)256 * DM * 2};
        pg8::EpiSwiglu E{ACT, DFF};
        pg8::gemm_phase(F.lds, DM * 2, DM * 2 / 128, Sd, E);
    }
    SEAM(9);

    PHASE(10) {
        pg8::SchedPlain Sd{(const char*)ACT, (const char*)WDN, S / 256, DM / 256, F.G, gcid, (size_t)256 * DFF * 2};
        pg8::EpiResid E{X1, X2, DM, nullptr, 1.f};
        pg8::gemm_phase(F.lds, DFF * 2, DFF * 2 / 128, Sd, E);
    }
    SEAM(10);

    PHASE(11) {
        LAS float* part = (LAS float*)F.lds;
        LAS float* rs = part + 47 * NWAVES;
        const int RB = S / F.G, r0 = F.vcu * RB;
        const int c4 = tid * 4, grp = wave >> 1;
        const f32x4 g4 = *(const f32x4*)(args.in[13] + c4);
        const float* xc = X2 + c4;
        for (int rb = r0; rb < r0 + RB; rb += 32) {
            f32x4 v[32], h[15];
#pragma unroll
            for (int i = 0; i < 32; ++i) v[i] = *(const f32x4*)(xc + (size_t)(rb + i) * DM);
#pragma unroll
            for (int j = 0; j < 15; ++j) { const int row = rb - 1 - j; h[j] = *(const f32x4*)(xc + (size_t)((row >= 0) ? row : rb) * DM) * ((row >= 0) ? 1.f : 0.f); }
#pragma unroll
            for (int k = 0; k < 47; ++k) { const f32x4 x = (k < 15) ? h[(k < 15) ? 14 - k : 0] : v[(k >= 15) ? k - 15 : 0];
                const float s = wave_sum((x.x * x.x + x.y * x.y) + (x.z * x.z + x.w * x.w)); if (lane == 0) part[k * NWAVES + wave] = s; }
            __syncthreads();
            if (tid < 47) { float s = 0.f;
#pragma unroll
                for (int w = 0; w < NWAVES; ++w) s += part[tid * NWAVES + w];
                rs[tid] = 1.f / sqrtf(s * (1.f / DM) + RMS_EPS); }
            __syncthreads();
            bf16_t* po = POOLED + ((size_t)grp * S + rb) * 512 + (c4 & 511);
#define POOL_BODY(W) do { f32x4 s4 = (f32x4){0.f, 0.f, 0.f, 0.f}; \
            _Pragma("unroll") for (int j = 1; j < (W); ++j) s4 += h[j - 1] * rs[15 - j]; \
            _Pragma("unroll") for (int i = 0; i < 32; ++i) { const int t = rb + i; const f32x4 vi = v[i] * rs[15 + i]; \
                s4 += vi; \
                const float rc = 1.f / (float)((t + 1 < (W)) ? (t + 1) : (W)); \
                const f32x4 p = (s4 * rc - vi) * g4; \
                s4 -= ((i - (W) + 1 >= 0) ? v[(i - (W) + 1 >= 0) ? i - (W) + 1 : 0] : h[((W) - 2 - i >= 0) ? (W) - 2 - i : 0]) * rs[15 + i - (W) + 1];        \
                u32x2 w; w.x = cvt_pk_bf16(p.x, p.y); w.y = cvt_pk_bf16(p.z, p.w); \
                *(u32x2*)(po + (size_t)i * 512) = w; } } while (0)
            if (grp == 0) POOL_BODY(2); else if (grp == 1) POOL_BODY(4); else if (grp == 2) POOL_BODY(8); else POOL_BODY(16);
#undef POOL_BODY
            __syncthreads();
        }
    }
    SEAM(11);

    PHASE(12) {
        pg8::SchedPool Sd{(const char*)POOLED, (const char*)WPOOL, S / 256, DM / 256, F.G, gcid, (size_t)256 * 512 * 2, (size_t)S * 512 * 2};
        pg8::EpiResid E{X2, X3, DM, args.in[15], 1.f};
        pg8::gemm_phase(F.lds, 512 * 2, 8, Sd, E);
    }
    SEAM(12);

    PHASE(13) {
        const int RB = S / F.G, r0 = F.vcu * RB;
        LAS unsigned* es = (LAS unsigned*)F.lds;
        const float* gain = args.in[16]; const float* router = args.in[17];
        for (int ib = 4 * wave; ib < RB; ib += 4 * NWAVES) {
            float ss[4], lg[4][8];
#pragma unroll
            for (int q = 0; q < 4; ++q) { ss[q] = 0.f;
#pragma unroll
                for (int e = 0; e < 8; ++e) lg[q][e] = 0.f; }
            f32x4 xn[4];
#pragma unroll
            for (int q = 0; q < 4; ++q) xn[q] = *(const f32x4*)(X3 + (size_t)(r0 + ib + q) * DM + 4 * lane);
#pragma unroll 1
            for (int j = 0; j < 8; ++j) { const int k0 = 4 * (lane + 64 * j); const f32x4 g = *(const f32x4*)(gain + k0);
                f32x4 rr[4][2];
#pragma unroll
                for (int c = 0; c < 4; ++c) { rr[c][0] = *(const f32x4*)(router + (size_t)(k0 + c) * 8); rr[c][1] = *(const f32x4*)(router + (size_t)(k0 + c) * 8 + 4); }
                f32x4 xq[4];
#pragma unroll
                for (int q = 0; q < 4; ++q) xq[q] = xn[q];
                if (j < 7) {
#pragma unroll
                    for (int q = 0; q < 4; ++q) xn[q] = *(const f32x4*)(X3 + (size_t)(r0 + ib + q) * DM + k0 + 256); }
#pragma unroll
                for (int q = 0; q < 4; ++q) { const f32x4 x = xq[q]; ss[q] += (x.x * x.x + x.y * x.y) + (x.z * x.z + x.w * x.w); xq[q] = x * g; }
#pragma unroll
                for (int c = 0; c < 4; ++c) { const f32x4 ra = rr[c][0], rb = rr[c][1];
#pragma unroll
                    for (int q = 0; q < 4; ++q) { const float hv = xq[q][c];
                        lg[q][0] += hv * ra.x; lg[q][1] += hv * ra.y; lg[q][2] += hv * ra.z; lg[q][3] += hv * ra.w; lg[q][4] += hv * rb.x; lg[q][5] += hv * rb.y; lg[q][6] += hv * rb.z; lg[q][7] += hv * rb.w; } } }
            float rstd[4];
#pragma unroll
            for (int q = 0; q < 4; ++q) rstd[q] = 1.f / sqrtf(wave_sum(ss[q]) * (1.f / DM) + RMS_EPS);
#pragma unroll
            for (int q = 0; q < 4; ++q) { const int t = r0 + ib + q;
#pragma unroll
                for (int e = 0; e < 8; ++e) lg[q][e] = wave_sum(lg[q][e]) * rstd[q];
                int e1 = 0; float v1 = lg[q][0];
#pragma unroll
                for (int e = 1; e < 8; ++e) if (lg[q][e] > v1) { v1 = lg[q][e]; e1 = e; }
                int e2 = -1; float v2 = -__builtin_inff();
#pragma unroll
                for (int e = 0; e < 8; ++e) if (e != e1 && lg[q][e] > v2) { v2 = lg[q][e]; e2 = e; }
                const float g1 = 1.f / (1.f + __expf(v2 - v1)), g2 = 1.f - g1;
                if (lane == 0) { TOKE[t] = (unsigned)e1 | ((unsigned)e2 << 8); TOKG[t] = (f32x2){g1, g2}; RSTD3[t] = rstd[q]; es[ib + q] = (unsigned)e1 | ((unsigned)e2 << 8); } }
        }
        __syncthreads();
        if (tid < 8) { unsigned c = 0; for (int i = 0; i < RB; ++i) { const unsigned w = es[i]; c += ((w & 255u) == (unsigned)tid) + (((w >> 8) & 255u) == (unsigned)tid); } CNT[F.vcu * 8 + tid] = c; }
        __syncthreads();
    }
    SEAM(13);

    PHASE(14) {
        const int RB = S / F.G, r0 = F.vcu * RB;
        LAS unsigned* cnts = (LAS unsigned*)F.lds;
        LAS unsigned* tot = cnts + 2048; LAS unsigned* offs = tot + 8; LAS unsigned* base = offs + 8; LAS unsigned* es = base + 8; LAS unsigned* sl = es + 64;
        for (int i = tid; i < F.G * 8; i += NTHREADS) cnts[i] = CNT[i];
        if (tid < RB) es[tid] = TOKE[r0 + tid];
        __syncthreads();
        { unsigned t_ = 0, o_ = 0;
          for (int w = lane; w < F.G; w += 64) { const unsigned c = cnts[w * 8 + wave]; t_ += c; if (w < F.vcu) o_ += c; }
#pragma unroll
          for (int o = 1; o < 64; o <<= 1) { t_ += __shfl_xor(t_, o); o_ += __shfl_xor(o_, o); }
          if (lane == 0) { tot[wave] = t_; offs[wave] = o_; } }
        __syncthreads();
        if (tid == 0) { unsigned b = 0; for (int e = 0; e < 8; ++e) { base[e] = b; b += (tot[e] + 255u) & ~255u; }
            if (blockIdx.x == 0) { int pm = 0; for (int e = 0; e < 8; ++e) { const int nt_ = (int)((tot[e] + 255u) >> 8); for (int i = 0; i < nt_; ++i) TEXP[pm++] = e; } TEXP[127] = pm; { int cu = 0; for (int e = 0; e < 7; ++e) { cu += (int)((tot[e] + 255u) >> 8); TEXP[112 + e] = cu; } } } }
        __syncthreads();
        if (tid < RB) { const unsigned w = es[tid]; const unsigned e1 = w & 255u, e2 = (w >> 8) & 255u; unsigned k1 = 0, k2 = 0;
            for (int i = 0; i < tid; ++i) { const unsigned o = es[i]; const unsigned a = o & 255u, b = (o >> 8) & 255u; k1 += (a == e1) + (b == e1); k2 += (a == e2) + (b == e2); }
            const unsigned s1 = base[e1] + offs[e1] + k1, s2 = base[e2] + offs[e2] + k2;
            sl[2 * tid] = s1; sl[2 * tid + 1] = s2; SLOT[r0 + tid] = (u32x2){s1, s2}; }
        __syncthreads();
        const float* gain = args.in[16];
        for (int i = wave; i < RB; i += NWAVES) { const int t = r0 + i; const float rstd = RSTD3[t] * F8_HSCALE;
            const f32x4* xr = (const f32x4*)(X3 + (size_t)t * DM) + lane; const f32x4* gr = (const f32x4*)gain + lane;
            unsigned* o1 = (unsigned*)(HS8 + (size_t)sl[2 * i] * DM) + lane; unsigned* o2 = (unsigned*)(HS8 + (size_t)sl[2 * i + 1] * DM) + lane;
#pragma unroll
            for (int j = 0; j < 8; ++j) { const f32x4 v = xr[64 * j], g = gr[64 * j]; const unsigned w = pk4_fp8(v.x * rstd * g.x, v.y * rstd * g.y, v.z * rstd * g.z, v.w * rstd * g.w); o1[64 * j] = w; o2[64 * j] = w; } }
        if (blockIdx.x < 8) { const int e = blockIdx.x; const unsigned p0 = base[e] + tot[e], p1 = base[e] + ((tot[e] + 255u) & ~255u);
            for (unsigned r = p0 + wave; r < p1; r += NWAVES) { u32x2* o = (u32x2*)(HS8 + (size_t)r * DM) + lane;
#pragma unroll
                for (int j = 0; j < 4; ++j) o[64 * j] = (u32x2){0u, 0u}; } }
        __syncthreads();
        { unsigned* const cq = (unsigned*)(ws + WS_CTL) + 3072;
          for (;;) {
            if (tid == 0) MISC[15] = __hip_atomic_fetch_add(cq, 4u, __ATOMIC_RELAXED, __HIP_MEMORY_SCOPE_AGENT);
            __syncthreads();
            const unsigned b0 = MISC[15];
            if (b0 >= (unsigned)MOE_NB) break;
#pragma unroll 1
            for (int q = 0; q < 4; ++q) if (b0 + q < (unsigned)MOE_NB) moe_cvt_batch(args.in[18], args.in[19], args.in[20], ws, (int)(b0 + q), wave, lane);
            __syncthreads();
            if (b0 + 4u >= (unsigned)MOE_NB_GU) break;
          } }
    }
    SEAM(14);

    PHASE(15) {
        const int ntile = __builtin_amdgcn_readfirstlane(TEXP[127]);
        pg8::ExpCum cum; { const int cv = (lane < 7) ? TEXP[112 + lane] : 0;
#pragma unroll
            for (int j = 0; j < 7; ++j) cum.c[j] = __builtin_amdgcn_readlane(cv, j); }
        pg8::SchedMoe Sd{(const char*)HS8, (const char*)MWGU8, cum, ntile, 2 * DFFE / 256, F.G, gcid, (size_t)256 * DM, (size_t)14336 * DM, 0};
        pg8::EpiSwigluF8 E{ACTM8, DFFE, 1.f / (F8_HSCALE * F8_WSCALE), F8_ASCALE};
        pg8::gemm_phase<pg8::EpiSwigluF8, pg8::SchedMoe, true>(F.lds, DM, DM / 128, Sd, E);
        { unsigned* const cq = (unsigned*)(ws + WS_CTL) + 3072;
          for (;;) {
            __syncthreads();
            if (tid == 0) MISC[15] = __hip_atomic_fetch_add(cq, 4u, __ATOMIC_RELAXED, __HIP_MEMORY_SCOPE_AGENT);
            __syncthreads();
            const unsigned b0 = MISC[15];
            if (b0 >= (unsigned)MOE_NB) break;
#pragma unroll 1
            for (int q = 0; q < 4; ++q) if (b0 + q < (unsigned)MOE_NB) moe_cvt_batch(args.in[18], args.in[19], args.in[20], ws, (int)(b0 + q), wave, lane);
          } }
    }
    SEAM(15);

    PHASE(16) {
        const int ntile = __builtin_amdgcn_readfirstlane(TEXP[127]);
        pg8::ExpCum cum; { const int cv = (lane < 7) ? TEXP[112 + lane] : 0;
#pragma unroll
            for (int j = 0; j < 7; ++j) cum.c[j] = __builtin_amdgcn_readlane(cv, j); }
        const int nsplit = ntile & 31;
        { pg8::SchedMoe Sd{(const char*)ACTM8, (const char*)MWDN8, cum, ntile - nsplit, DM / 256, F.G, gcid, (size_t)256 * DFFE, (size_t)DM * DFFE, 0};
          pg8::EpiStoreBf16 E{YM, DM, 1.f / (F8_ASCALE * F8_WSCALE)};
          pg8::gemm_phase<pg8::EpiStoreBf16, pg8::SchedMoe, true>(F.lds, DFFE, DFFE / 128, Sd, E); }
        if (nsplit > 0 && nsplit <= 8) {
          pg8::SchedMoeSplit Sd{(const char*)ACTM8, (const char*)MWDN8, cum, ntile - nsplit, 32 * nsplit, F.G, gcid, (size_t)256 * DFFE, (size_t)DM * DFFE, (size_t)(DFFE / 4)};
          pg8::EpiResid E{nullptr, YMP, DM, nullptr, 1.f / (F8_ASCALE * F8_WSCALE)};
          pg8::gemm_phase<pg8::EpiResid, pg8::SchedMoeSplit, true>(F.lds, DFFE, DFFE / 4 / 128, Sd, E); }
        else if (nsplit > 8) {
          pg8::SchedMoe Sd{(const char*)ACTM8 + (size_t)(ntile - nsplit) * 256 * DFFE, (const char*)MWDN8, cum, nsplit, DM / 256, F.G, gcid, (size_t)256 * DFFE, (size_t)DM * DFFE, ntile - nsplit};
          pg8::EpiStoreBf16 E{YM + (size_t)(ntile - nsplit) * 256 * DM, DM, 1.f / (F8_ASCALE * F8_WSCALE)};
          pg8::gemm_phase<pg8::EpiStoreBf16, pg8::SchedMoe, true>(F.lds, DFFE, DFFE / 128, Sd, E); }
    }
    SEAM(16);

    PHASE(17) {
        const int ntile = __builtin_amdgcn_readfirstlane(TEXP[127]); const int nsp = ntile & 31, sbase = (nsp > 0 && nsp <= 8) ? (ntile - nsp) * 256 : (1 << 30);
        for (int t = gw; t < S; t += NGW) { const u32x2 sl = SLOT[t]; const f32x2 g = TOKG[t];
            const f32x4* xr = (const f32x4*)(X3 + (size_t)t * DM) + lane; f32x4* o = (f32x4*)(args.out + (size_t)t * DM) + lane;
            f32x4 y[2][8];
#pragma unroll
            for (int q = 0; q < 2; ++q) { const int s_ = (int)(q ? sl.y : sl.x);
                if (s_ < sbase) { const u32x2* yp = (const u32x2*)(YM + (size_t)s_ * DM) + lane;
#pragma unroll
                    for (int j = 0; j < 8; ++j) { const u32x2 w = yp[64 * j]; y[q][j] = (f32x4){bf_lo(w.x), bf_hi(w.x), bf_lo(w.y), bf_hi(w.y)}; } }
                else { const f32x4* yp = (const f32x4*)(YMP + (size_t)(s_ - sbase) * DM) + lane;
#pragma unroll
                    for (int j = 0; j < 8; ++j) y[q][j] = (yp[64 * j] + yp[64 * j + (size_t)2048 * DM / 4]) + (yp[64 * j + (size_t)2 * 2048 * DM / 4] + yp[64 * j + (size_t)3 * 2048 * DM / 4]); } }
#pragma unroll
            for (int j = 0; j < 8; ++j) o[64 * j] = xr[64 * j] + (y[0][j] * g.x + y[1][j] * g.y); }
    }
#undef IN
#undef SEAM
}

extern "C" void kernel_launch(void* const* d_in, const int* in_sizes, int n_in, void* d_out, int out_size, void* d_ws, size_t ws_size, hipStream_t stream) {
    static int grid = 0;
    if (grid == 0) {
        if (n_in != 21 || in_sizes[0] != S * DM || out_size != S * DM || ws_size < WS_END) { fprintf(stderr, "kernel_launch: unexpected shapes (n_in %d, in0 %d, out %d, ws %zu)\n", n_in, n_in > 0 ? in_sizes[0] : -1, out_size, ws_size); grid = -1; return; }
        int dev = 0, cus = 0, per_cu = 0;
        if (hipGetDevice(&dev) != hipSuccess || hipDeviceGetAttribute(&cus, hipDeviceAttributeMultiprocessorCount, dev) != hipSuccess) { grid = -1; return; }
        if (hipFuncSetAttribute((const void*)mega_fwd, hipFuncAttributeMaxDynamicSharedMemorySize, LDS_BYTES) != hipSuccess) { fprintf(stderr, "kernel_launch: hipFuncSetAttribute failed\n"); grid = -1; return; }
        if (hipOccupancyMaxActiveBlocksPerMultiprocessor(&per_cu, (const void*)mega_fwd, NTHREADS, LDS_BYTES) != hipSuccess || per_cu < 1) fprintf(stderr, "kernel_launch: occupancy query reports %d\n", per_cu);
        (void)hipGetLastError();
        grid = cus;
        while (grid > 1 && (S % grid != 0 || grid > 256)) --grid;
    }
    if (grid < 0) return;
    (void)hipMemsetAsync((char*)d_ws + WS_CTL, 0, CTL_ZERO_BYTES, stream);
    Args a{};
    for (int i = 0; i < 21; ++i) a.in[i] = (const float*)d_in[i];
    a.out = (float*)d_out; a.ws = (unsigned char*)d_ws;
#if MK_FUSED
#if MK_PROBE_HI > 0
    a.ph_lo = 0; a.ph_hi = MK_PROBE_HI;
    hipLaunchKernelGGL(mega_fwd, dim3(grid), dim3(NTHREADS), LDS_BYTES, stream, a);
    (void)hipMemsetAsync((char*)d_ws + WS_CTL, 0, CTL_ZERO_BYTES, stream);
    a.ph_lo = MK_PROBE_LO; a.ph_hi = 18;
    hipLaunchKernelGGL(mega_fwd, dim3(grid), dim3(NTHREADS), LDS_BYTES, stream, a);
#else
    a.ph_lo = 0; a.ph_hi = 18;
    hipLaunchKernelGGL(mega_fwd, dim3(grid), dim3(NTHREADS), LDS_BYTES, stream, a);
#endif
#else
    for (int p = 0; p < 18; ++p) { a.ph_lo = p; a.ph_hi = p + 1; hipLaunchKernelGGL(mega_fwd, dim3(grid), dim3(NTHREADS), LDS_BYTES, stream, a); }
#endif
}
```

```cpp
#include <hip/hip_runtime.h>
#include <cstdio>
#include <cstdint>

#ifndef MK_ATT_MODES
#define MK_ATT_MODES 3
#endif
#ifndef MK_NAIVE_ATTN
#define MK_NAIVE_ATTN 0
#endif
#ifndef MK_PROBE_HI
#define MK_PROBE_LO 0
#define MK_PROBE_HI 0
#endif
#ifndef MK_FUSED
#define MK_FUSED 1
#endif

#define GAS __attribute__((address_space(1)))
#define LAS __attribute__((address_space(3)))
typedef unsigned short bf16_t;
typedef short bf16x8 __attribute__((ext_vector_type(8)));
typedef float f32x4 __attribute__((ext_vector_type(4)));
typedef float f32x2 __attribute__((ext_vector_type(2)));
typedef float f32x16 __attribute__((ext_vector_type(16)));
typedef unsigned u32x4 __attribute__((ext_vector_type(4)));
typedef unsigned u32x2 __attribute__((ext_vector_type(2)));
typedef int i32x4 __attribute__((ext_vector_type(4)));
typedef int i32x8 __attribute__((ext_vector_type(8)));

extern "C" __device__ int wl_i32(int, int, int) __asm("llvm.amdgcn.writelane.i32");
#define LDS_WAIT() asm volatile("s_waitcnt lgkmcnt(0)" ::: "memory")
#define VM_WAIT() asm volatile("s_waitcnt vmcnt(0)" ::: "memory")

constexpr int S = 8192, DM = 2048, NINP = 8448  , DFF = 5632, DFFE = 7168, NEXP = 8;
constexpr int NH = 8, HD = 128, NIH = 16, IDD = 64, TOPK = 256;
constexpr int MAXSLOT = 18432;
constexpr float RMS_EPS = 1e-6f;
constexpr float ATT_SCALE = 0.08838834764831845f;
constexpr int NWAVES = 8, NTHREADS = 512;

constexpr int C_QA = 0, C_KA = 1024, C_VA = 2048, C_QI = 3072, C_QB = 4096, C_KB = 5120, C_VB = 6144, C_GB = 7168, C_KI = 8192, C_WI = 8256, C_FB = 8272;

constexpr size_t MiB = 1u << 20;
constexpr size_t WS_CTL = 0, CTL_ZERO_BYTES = 32 * 1024;
constexpr size_t WS_WI = 1 * MiB;
constexpr size_t WS_LOGF = 1 * MiB + 512 * 1024;
constexpr size_t WS_CC = 1 * MiB + 768 * 1024;
constexpr size_t WS_TOKE = 2 * MiB;
constexpr size_t WS_TOKG = 2 * MiB + 32 * 1024;
constexpr size_t WS_RSTD3 = 2 * MiB + 96 * 1024;
constexpr size_t WS_SLOT = 2 * MiB + 128 * 1024;
constexpr size_t WS_CNT = 2 * MiB + 192 * 1024;
constexpr size_t WS_TEXP = 2 * MiB + 200 * 1024;
constexpr size_t WS_KI = 3 * MiB;
constexpr size_t WS_QX = 4 * MiB;
constexpr size_t WS_KX = 5 * MiB;
constexpr size_t WS_NQB = 6 * MiB;
constexpr size_t WS_NKB = 6 * MiB + 256 * 1024;
constexpr size_t WS_JLO = 6 * MiB + 512 * 1024;
constexpr size_t WS_ROT = 7 * MiB;
constexpr size_t WS_WIN = 8 * MiB;
constexpr size_t WS_WOUT = 41 * MiB;
constexpr size_t WS_WGU = 49 * MiB;
constexpr size_t WS_WDN = 93 * MiB;
constexpr size_t WS_WPOOL = 115 * MiB;
constexpr size_t WS_MWGU = 117 * MiB;
constexpr size_t WS_MWDN = 565 * MiB;
constexpr size_t WS_BIG1 = 789 * MiB;
constexpr size_t WS_BIG2 = 1045 * MiB;
constexpr size_t WS_ATT = 1189 * MiB;
constexpr size_t WS_MASK = 1319 * MiB;
constexpr size_t WS_O = 1327 * MiB;
constexpr size_t WS_H = 1359 * MiB;
constexpr size_t WS_X1 = 1391 * MiB;
constexpr size_t WS_X2 = 1455 * MiB;
constexpr size_t WS_YMP = 1520 * MiB;
constexpr size_t WS_PART = 1584 * MiB;
constexpr size_t WS_QLIN = 1617 * MiB;
constexpr size_t WS_END = 1618 * MiB;
constexpr int CW_BAR = 4096;

constexpr int RING_BYTES = 131072;
constexpr int MISC_OFF = RING_BYTES + 320;
constexpr int LDS_BYTES = 147456;

__device__ __forceinline__ unsigned cvt_pk_bf16(float lo, float hi) { unsigned r; asm volatile("v_cvt_pk_bf16_f32 %0, %1, %2" : "=v"(r) : "v"(lo), "v"(hi)); return r; }
__device__ __forceinline__ float bf_lo(unsigned w) { return __uint_as_float(w << 16); }
__device__ __forceinline__ float bf_hi(unsigned w) { return __uint_as_float(w & 0xffff0000u); }
__device__ __forceinline__ float bf1(bf16_t b) { return __uint_as_float(((unsigned)b) << 16); }
#define WS_DPP(v, ctrl) __builtin_bit_cast(float, __builtin_amdgcn_update_dpp(0, __builtin_bit_cast(int, (v)), (ctrl), 0xF, 0xF, true))
__device__ __forceinline__ float wave_sum(float v) {
    v += WS_DPP(v, 0xB1);
    v += WS_DPP(v, 0x4E);
    v += WS_DPP(v, 0x141);
    v += WS_DPP(v, 0x140);
    const int iv = __builtin_bit_cast(int, v);
    const float s0 = __builtin_bit_cast(float, __builtin_amdgcn_readlane(iv, 0)), s1 = __builtin_bit_cast(float, __builtin_amdgcn_readlane(iv, 16));
    const float s2 = __builtin_bit_cast(float, __builtin_amdgcn_readlane(iv, 32)), s3 = __builtin_bit_cast(float, __builtin_amdgcn_readlane(iv, 48));
    return (s0 + s1) + (s2 + s3);
}
__device__ __forceinline__ float sigmoidf_(float z) { return 1.f / (1.f + __expf(-z)); }
__device__ __forceinline__ unsigned pk4_fp8(float a, float b, float c, float d) {
    a = __builtin_amdgcn_fmed3f(a, -448.f, 448.f); b = __builtin_amdgcn_fmed3f(b, -448.f, 448.f); c = __builtin_amdgcn_fmed3f(c, -448.f, 448.f); d = __builtin_amdgcn_fmed3f(d, -448.f, 448.f);
    int w = __builtin_amdgcn_cvt_pk_fp8_f32(a, b, 0, false); w = __builtin_amdgcn_cvt_pk_fp8_f32(c, d, w, true); return (unsigned)w; }
constexpr float F8_WSCALE = 512.f, F8_HSCALE = 16.f, F8_ASCALE = 8.f;

#define XB_TMO      128
#define XB_XCNT(j)  (256  + 64 * (j))
#define XB_XSUB(j)  (1280 + 64 * (j))
#define XB_XGEN(j)  (2304 + 64 * (j))
#define XB_TOP      3328
#define XB_TOPGEN   3392
#define XCD_BAR_WORDS 3456
#define XB_SPIN_CAP (1u << 22)

__device__ __forceinline__ unsigned xb_ld(unsigned* p)              { return __hip_atomic_load(p, __ATOMIC_RELAXED, __HIP_MEMORY_SCOPE_AGENT); }
__device__ __forceinline__ unsigned xb_add(unsigned* p, unsigned v) { return __hip_atomic_fetch_add(p, v, __ATOMIC_RELAXED, __HIP_MEMORY_SCOPE_AGENT); }
__device__ __forceinline__ unsigned xb_xcc_id() { return (unsigned)__builtin_amdgcn_s_getreg((3 << 11) | 20) & 0xFu; }
#define XB_SPIN(cond, bar) do { unsigned _sp = 0; while (cond) { __builtin_amdgcn_s_sleep(1); \
    if ((++_sp & 255u) == 0u) { if (xb_ld(&(bar)[XB_TMO])) break; if (_sp > XB_SPIN_CAP) { atomicAdd(&(bar)[XB_TMO], 1u); break; } } } } while (0)

struct XcdBarrier { unsigned* bar; unsigned x; volatile LAS unsigned* st; };

__device__ __forceinline__ XcdBarrier xcd_barrier_post(unsigned* bar, volatile LAS unsigned* st) {
    XcdBarrier b; b.bar = bar; b.x = xb_xcc_id(); b.st = st;
    if (threadIdx.x == 0) (void)xb_add(&bar[XB_XCNT(b.x)], 1u);
    return b;
}
__device__ __forceinline__ void xcd_barrier_complete(unsigned* bar, unsigned x, unsigned& nloc, unsigned& nx) {
    const unsigned G = gridDim.x * gridDim.y * gridDim.z;
    unsigned sum, cnt, mine, sp = 0u;
    for (;;) {
        sum = 0u; cnt = 0u; mine = 0u;
#pragma unroll
        for (unsigned j = 0; j < 16; ++j) { const unsigned c = xb_ld(&bar[XB_XCNT(j)]); sum += c; cnt += (c > 0u) ? 1u : 0u; mine = (j == x) ? c : mine; }
        if (sum == G) break;
        __builtin_amdgcn_s_sleep(1);
        if ((++sp & 255u) == 0u) { if (xb_ld(&bar[XB_TMO])) break; if (sp > XB_SPIN_CAP) { atomicAdd(&bar[XB_TMO], 1u); break; } }
    }
    nloc = mine > 0u ? mine : 1u; nx = cnt > 0u ? cnt : 1u;
}
__device__ __forceinline__ void xcd_barrier(const XcdBarrier& b) {
    asm volatile("s_waitcnt vmcnt(0)" ::: "memory");
    __syncthreads();
    if (threadIdx.x == 0) {
        unsigned* bar = b.bar;
        __builtin_amdgcn_s_waitcnt(0);
        unsigned nloc = b.st[0], nx = b.st[1];
        if (nloc == 0u) { xcd_barrier_complete(bar, b.x, nloc, nx); b.st[0] = nloc; b.st[1] = nx; }
        const unsigned old = xb_add(&bar[XB_XSUB(b.x)], 1u);
        const unsigned gen = old / nloc;
        if (old + 1u == (gen + 1u) * nloc) {
            __builtin_amdgcn_fence(__ATOMIC_RELEASE, "agent");
            asm volatile("s_waitcnt vmcnt(0)" ::: "memory");
            const unsigned og = xb_add(&bar[XB_TOP], 1u);
            const unsigned tg = og / nx;
            if (og + 1u == (tg + 1u) * nx) xb_add(&bar[XB_TOPGEN], 1u);
            else XB_SPIN(xb_ld(&bar[XB_TOPGEN]) == tg, bar);
            __builtin_amdgcn_fence(__ATOMIC_ACQUIRE, "agent");
            xb_add(&bar[XB_XGEN(b.x)], 1u);
            asm volatile("s_waitcnt vmcnt(0)" ::: "memory");
        } else {
            XB_SPIN(xb_ld(&bar[XB_XGEN(b.x)]) == gen, bar);
            __builtin_amdgcn_fence(__ATOMIC_ACQUIRE, "agent");
            asm volatile("s_waitcnt vmcnt(0)" ::: "memory");
        }
    }
    __syncthreads();
}

namespace pg8 {
constexpr int BM = 256, BK = 64, HALF = 128, HTB = HALF * BK * 2, STAGE_BYTES = 8 * HTB, NXCD = 8, WGM = 8;
__host__ __device__ __forceinline__ int lds_byte(int r, int c) { const int st = (r >> 4) * 2 + (c >> 5), rr = r & 15, cc = c & 31, ob = rr * 64 + cc * 2; return st * 1024 + (ob ^ (((ob >> 9) & 1) << 5)); }
__host__ __device__ __forceinline__ void stage_rc(int b, int& R, int& C) { const int st = b / 1024, sb = b % 1024, swz = sb ^ (((sb >> 9) & 1) << 5); R = (st >> 1) * 16 + swz / 64; C = (st & 1) * 32 + (swz % 64) / 2; }
__host__ __device__ __forceinline__ int perm32(int rho) { const int n = rho >> 4, i = rho & 15; return 8 * (i >> 2) + 4 * n + (i & 3); }

__device__ __forceinline__ void glds16_s(const void* sbase, unsigned voff, unsigned lds_dst) {
    unsigned keep;
    asm volatile("s_mov_b32 %0, m0\n\ts_mov_b32 m0, %3\n\ts_nop 0\n\tglobal_load_lds_dwordx4 %1, %2\n\ts_mov_b32 m0, %0" : "=&s"(keep) : "v"(voff), "s"(sbase), "s"(lds_dst) : "memory");
}
struct Unit { int pm, pn; const char* A; const char* B; };

__device__ __forceinline__ bool order_tile(int i, int G, int c, int nM, int nN, int& pm, int& pn) {
    const int nwg = nM * nN; const int L = i * G + c; if (L >= nwg) return false;
    int wgid = L; { const int q = nwg / NXCD, r = nwg % NXCD, xcd = wgid % NXCD, off = wgid / NXCD; wgid = (xcd < r ? xcd * (q + 1) : r * (q + 1) + (xcd - r) * q) + off; }
    const int nig = WGM * nN, gid = wgid / nig, fm = gid * WGM, gsz = (nM - fm) < WGM ? (nM - fm) : WGM;
    pm = fm + ((wgid % nig) % gsz); pn = (wgid % nig) / gsz; return true;
}
struct SchedPlain {
    const char* A0; const char* B0; int nM, nN, G, c; size_t tstep;
    __device__ __forceinline__ bool next(int i, Unit& u) const { if (!order_tile(i, G, c, nM, nN, u.pm, u.pn)) return false; u.A = A0 + (size_t)u.pm * tstep; u.B = B0 + (size_t)u.pn * tstep; return true; }
};
struct SchedPool {
    const char* A0; const char* B0; int nM, nN, G, c; size_t tstep, groupA;
    __device__ __forceinline__ bool next(int i, Unit& u) const { if (!order_tile(i, G, c, nM, nN, u.pm, u.pn)) return false; u.A = A0 + (size_t)(u.pn >> 1) * groupA + (size_t)u.pm * tstep; u.B = B0 + (size_t)u.pn * tstep; return true; }
};
struct ExpCum { int c[7]; __device__ __forceinline__ int expert(int pm) const { int e = 0;
#pragma unroll
        for (int j = 0; j < 7; ++j) e += (pm >= c[j]) ? 1 : 0; return e; } };
struct SchedMoe {
    const char* A0; const char* B0; ExpCum cum; int nM, nN, G, c; size_t tstep, expB; int pm0;
    __device__ __forceinline__ bool next(int i, Unit& u) const { if (!order_tile(i, G, c, nM, nN, u.pm, u.pn)) return false; const int e = cum.expert(u.pm + pm0);
        u.A = A0 + (size_t)u.pm * tstep; u.B = B0 + (size_t)e * expB + (size_t)u.pn * tstep; return true; }
};

struct SchedMoeSplit {
    const char* A0; const char* B0; ExpCum cum; int base, nunits, G, c; size_t tstep, expB, kq_bytes;
    __device__ __forceinline__ bool next(int i, Unit& u) const { const int L = i * G + c; if (L >= nunits) return false;
        const int kq = L & 3, pn = (L >> 2) & 7, loc = L >> 5, pm = base + loc; const int e = cum.expert(pm);
        u.pm = kq * 8 + loc; u.pn = pn; u.A = A0 + (size_t)pm * tstep + (size_t)kq * kq_bytes; u.B = B0 + (size_t)e * expB + (size_t)pn * tstep + (size_t)kq * kq_bytes; return true; }
};

struct EpiStoreBf16 {
    static constexpr bool PERM = true;
    bf16_t* O; int ldc; float scale;
    __device__ __forceinline__ void operator()(const f32x4 (&acc)[2][2][4][2], const Unit& u, int wr, int wc, int fr, int fq) const {
        const int row0 = u.pm * BM + wr * 64 + fr, col0 = u.pn * BM + wc * 32 + 8 * fq;
#pragma unroll
        for (int ai = 0; ai < 2; ++ai)
#pragma unroll
            for (int m = 0; m < 4; ++m) { bf16_t* rowp = O + (size_t)(row0 + ai * HALF + m * 16) * ldc + col0;
#pragma unroll
                for (int bj = 0; bj < 2; ++bj) { const f32x4 v0 = acc[ai][bj][m][0] * scale, v1 = acc[ai][bj][m][1] * scale;
                    u32x4 w; w.x = cvt_pk_bf16(v0[0], v0[1]); w.y = cvt_pk_bf16(v0[2], v0[3]); w.z = cvt_pk_bf16(v1[0], v1[1]); w.w = cvt_pk_bf16(v1[2], v1[3]);
                    *(u32x4*)(rowp + bj * HALF) = w; } }
    }
};
struct EpiInProj {
    static constexpr bool PERM = true;
    bf16_t* O; int ldc; bf16_t* VAo; bf16_t* VBo; bf16_t* GBo;
    __device__ __forceinline__ void operator()(const f32x4 (&acc)[2][2][4][2], const Unit& u, int wr, int wc, int fr, int fq) const {
        const int row0 = u.pm * BM + wr * 64 + fr, seg = u.pn >> 2, scol0 = (u.pn & 3) * BM + wc * 32 + 8 * fq;
        const int kind = (seg == 2 || seg == 6) ? 1 : ((seg == 7) ? 2 : 0);
        bf16_t* const Vb = (seg == 2) ? VAo : VBo;
#pragma unroll
        for (int ai = 0; ai < 2; ++ai)
#pragma unroll
            for (int m = 0; m < 4; ++m) { const int row = row0 + ai * HALF + m * 16;
#pragma unroll
                for (int bj = 0; bj < 2; ++bj) { f32x4 v0 = acc[ai][bj][m][0], v1 = acc[ai][bj][m][1]; const int sc = scol0 + bj * HALF;
                    bf16_t* p;
                    if (kind == 1) p = Vb + ((size_t)(sc >> 7) * S + row) * HD + (sc & 127);
                    else if (kind == 2) { p = GBo + (size_t)row * 1024 + sc;
#pragma unroll
                        for (int j = 0; j < 4; ++j) { v0[j] = __builtin_amdgcn_rcpf(1.f + __builtin_amdgcn_exp2f(-1.4426950408889634f * v0[j])); v1[j] = __builtin_amdgcn_rcpf(1.f + __builtin_amdgcn_exp2f(-1.4426950408889634f * v1[j])); } }
                    else p = O + (size_t)row * ldc + u.pn * BM + bj * HALF + wc * 32 + 8 * fq;
                    u32x4 w; w.x = cvt_pk_bf16(v0[0], v0[1]); w.y = cvt_pk_bf16(v0[2], v0[3]); w.z = cvt_pk_bf16(v1[0], v1[1]); w.w = cvt_pk_bf16(v1[2], v1[3]);
                    *(u32x4*)p = w; } }
    }
};
struct EpiSwiglu {
    static constexpr bool PERM = true;
    bf16_t* O; int ldc;
    __device__ __forceinline__ void operator()(const f32x4 (&acc)[2][2][4][2], const Unit& u, int wr, int wc, int fr, int fq) const {
        const int row0 = u.pm * BM + wr * 64 + fr, col0 = u.pn * HALF + wc * 32 + 8 * fq;
#pragma unroll
        for (int ai = 0; ai < 2; ++ai)
#pragma unroll
            for (int m = 0; m < 4; ++m) { bf16_t* rowp = O + (size_t)(row0 + ai * HALF + m * 16) * ldc + col0;
                f32x4 v[2];
#pragma unroll
                for (int n = 0; n < 2; ++n) { const f32x4 g = acc[ai][0][m][n], up = acc[ai][1][m][n];
#pragma unroll
                    for (int j = 0; j < 4; ++j) { const float e = __builtin_amdgcn_exp2f(-1.4426950408889634f * g[j]); v[n][j] = g[j] * __builtin_amdgcn_rcpf(1.f + e) * up[j]; } }
                u32x4 w; w.x = cvt_pk_bf16(v[0][0], v[0][1]); w.y = cvt_pk_bf16(v[0][2], v[0][3]); w.z = cvt_pk_bf16(v[1][0], v[1][1]); w.w = cvt_pk_bf16(v[1][2], v[1][3]);
                *(u32x4*)rowp = w; }
    }
};
struct EpiSwigluF8 {
    static constexpr bool PERM = true;
    unsigned char* O; int ldc; float sin_, sout;
    __device__ __forceinline__ void operator()(const f32x4 (&acc)[2][2][4][2], const Unit& u, int wr, int wc, int fr, int fq) const {
        const int row0 = u.pm * BM + wr * 64 + fr, col0 = u.pn * HALF + wc * 32 + 8 * fq;
#pragma unroll
        for (int ai = 0; ai < 2; ++ai)
#pragma unroll
            for (int m = 0; m < 4; ++m) { unsigned char* rowp = O + (size_t)(row0 + ai * HALF + m * 16) * ldc + col0;
                f32x4 v[2];
#pragma unroll
                for (int n = 0; n < 2; ++n) { const f32x4 g = acc[ai][0][m][n] * sin_, up = acc[ai][1][m][n] * (sin_ * sout);
#pragma unroll
                    for (int j = 0; j < 4; ++j) { const float e = __builtin_amdgcn_exp2f(-1.4426950408889634f * g[j]); v[n][j] = g[j] * __builtin_amdgcn_rcpf(1.f + e) * up[j]; } }
                u32x2 w; w.x = pk4_fp8(v[0][0], v[0][1], v[0][2], v[0][3]); w.y = pk4_fp8(v[1][0], v[1][1], v[1][2], v[1][3]);
                *(u32x2*)rowp = w; }
    }
};
struct EpiResid {
    static constexpr bool PERM = false;
    const float* res; float* out; int ldc; const float* cscale; float ascale;
    __device__ __forceinline__ void operator()(const f32x4 (&acc)[2][2][4][2], const Unit& u, int wr, int wc, int fr, int fq) const {
        const int row0 = u.pm * BM + wr * 64 + fr, col0 = u.pn * BM + wc * 32 + 4 * fq;
        f32x4 cs[2][2];
#pragma unroll
        for (int bj = 0; bj < 2; ++bj)
#pragma unroll
            for (int n = 0; n < 2; ++n) cs[bj][n] = (cscale ? *(const f32x4*)(cscale + col0 + bj * HALF + n * 16) : (f32x4){1.f, 1.f, 1.f, 1.f}) * ascale;
#pragma unroll
        for (int ai = 0; ai < 2; ++ai)
#pragma unroll
            for (int m = 0; m < 4; ++m) { const size_t off = (size_t)(row0 + ai * HALF + m * 16) * ldc + col0;
#pragma unroll
                for (int bj = 0; bj < 2; ++bj)
#pragma unroll
                    for (int n = 0; n < 2; ++n) { f32x4 v = acc[ai][bj][m][n] * cs[bj][n];
                        if (res) v += *(const f32x4*)(res + off + bj * HALF + n * 16);
                        *(f32x4*)(out + off + bj * HALF + n * 16) = v; }
                asm volatile("" ::: "memory"); }
    }
};

template <class Epi, class Sched, bool FP8 = false>
__device__ __forceinline__ void gemm_phase(LAS unsigned char* lds, const int Kb, const int nt  , const Sched& S, const Epi& E) {
    const int tid = threadIdx.x, wid = __builtin_amdgcn_readfirstlane(tid >> 6), lane = tid & 63, wr = wid >> 2, wc = wid & 3, fr = lane & 15, fq = lane >> 4;
    unsigned voffA, voffB;
    { int R, C; stage_rc(tid * 16, R, C); const int Rb = Epi::PERM ? ((R & ~31) + perm32(R & 31)) : R;
        voffA = (unsigned)(R * Kb + C * 2); voffB = (unsigned)(Rb * Kb + C * 2); }
    const size_t r64 = (size_t)64 * Kb;
    const size_t kstep = (size_t)(BK * 2);
    const size_t hstep = (size_t)HALF * Kb;
    const unsigned ldsw = (unsigned)wid * 1024u, ldsb = (unsigned)(uintptr_t)lds;
    const int aoff = lds_byte(wr * 64 + fr, fq * 8), boff = lds_byte(wc * 32 + fr, fq * 8);
#define PG8_SA(b, h) (((b) * 2 + (h)) * HTB)
#define PG8_SB(b, h) ((4 + (b) * 2 + (h)) * HTB)
#define PG8_STAGE(bufoff, gbase, voff) do { _Pragma("unroll") for (int _i = 0; _i < 2; ++_i) glds16_s((const void*)((const char*)(gbase) + _i * r64), (voff), ldsb + (unsigned)(bufoff) + ldsw + _i * 8192u); } while (0)
#define PG8_LD16(off) (*(const LAS bf16x8*)(lds + (off)))
#define PG8_CAT8(o_) __builtin_shufflevector(__builtin_bit_cast(i32x4, PG8_LD16(o_)), __builtin_bit_cast(i32x4, PG8_LD16((o_) + 1024)), 0, 1, 2, 3, 4, 5, 6, 7)
#define PG8_LDA(b, h) do { _Pragma("unroll") for (int m = 0; m < 4; ++m) { const int o_ = PG8_SA(b, h) + aoff + m * 2048; \
        if constexpr (FP8) A8[m] = PG8_CAT8(o_); else { At[m][0] = PG8_LD16(o_); At[m][1] = PG8_LD16(o_ + 1024); } } } while (0)
#define PG8_LDB(X, X8, b, h) do { _Pragma("unroll") for (int n = 0; n < 2; ++n) { const int o_ = PG8_SB(b, h) + boff + n * 2048; \
        if constexpr (FP8) X8[n] = PG8_CAT8(o_); else { X[n][0] = PG8_LD16(o_); X[n][1] = PG8_LD16(o_ + 1024); } } } while (0)
#define PG8_MMA(ai, bj, X, X8) do { if constexpr (!FP8) __builtin_amdgcn_s_setprio(1); _Pragma("unroll") for (int m = 0; m < 4; ++m) _Pragma("unroll") for (int n = 0; n < 2; ++n) { \
        if constexpr (FP8) acc[ai][bj][m][n] = __builtin_amdgcn_mfma_scale_f32_16x16x128_f8f6f4(X8[n], A8[m], acc[ai][bj][m][n], 0, 0, 0, 0x7f7f7f7f, 0, 0x7f7f7f7f); \
        else { _Pragma("unroll") for (int k = 0; k < 2; ++k) acc[ai][bj][m][n] = __builtin_amdgcn_mfma_f32_16x16x32_bf16(X[n][k], At[m][k], acc[ai][bj][m][n], 0, 0, 0); } } \
        if constexpr (!FP8) __builtin_amdgcn_s_setprio(0); } while (0)
#define PG8_WAIT_V(n) asm volatile("s_waitcnt vmcnt(" #n ")" ::: "memory")
#define PG8_WAIT_L(n) asm volatile("s_waitcnt lgkmcnt(" #n ")" ::: "memory")
#define PG8_BAR __builtin_amdgcn_s_barrier()
#define PG8_SCHED __builtin_amdgcn_sched_barrier(0)
#define PG8_HI do { if constexpr (FP8) asm volatile("s_setprio 1"); } while (0)
#define PG8_LO do { if constexpr (FP8) asm volatile("s_setprio 0"); } while (0)
    Unit cur, nxt; int ui = 0;
    if (!S.next(0, cur)) return;
    f32x4 acc[2][2][4][2];
#pragma unroll
    for (int a = 0; a < 2; ++a)
#pragma unroll
        for (int b = 0; b < 2; ++b)
#pragma unroll
            for (int m = 0; m < 4; ++m)
#pragma unroll
                for (int n = 0; n < 2; ++n) acc[a][b][m][n] = (f32x4){0.f, 0.f, 0.f, 0.f};
    bf16x8 At[4][2], B0[2][2], B1[2][2]; i32x8 A8[4], B08[2], B18[2];
    const char* cA = cur.A; const char* cB = cur.B;
    PG8_STAGE(PG8_SB(0, 0), cB, voffB); PG8_STAGE(PG8_SA(0, 0), cA, voffA); PG8_STAGE(PG8_SB(0, 1), cB + hstep, voffB); PG8_STAGE(PG8_SA(0, 1), cA + hstep, voffA);
    if (wr == 1) PG8_BAR;
    PG8_WAIT_V(4); PG8_BAR;
    PG8_STAGE(PG8_SB(1, 0), cB + kstep, voffB); PG8_STAGE(PG8_SA(1, 0), cA + kstep, voffA); PG8_STAGE(PG8_SB(1, 1), cB + hstep + kstep, voffB);
    PG8_WAIT_V(6); PG8_BAR;
    for (;;) {
        const bool has_next = S.next(ui + 1, nxt);
        const char* nA = has_next ? nxt.A : cA; const char* nB = has_next ? nxt.B : cB;
        for (int t = 0; t < nt; t += 2) {
            const bool last = (t == nt - 2);
            const char* a1 = cA + (size_t)(t + 1) * kstep;
            const char* a2 = last ? nA : cA + (size_t)(t + 2) * kstep; const char* b2 = last ? nB : cB + (size_t)(t + 2) * kstep;
            const char* a3 = a2 + kstep; const char* b3 = b2 + kstep;
            PG8_LDB(B0, B08, 0, 0); PG8_SCHED; PG8_LDA(0, 0); PG8_STAGE(PG8_SA(1, 1), a1 + hstep, voffA);
            PG8_WAIT_L(8); PG8_BAR; PG8_HI; PG8_WAIT_L(0); PG8_MMA(0, 0, B0, B08); PG8_BAR; PG8_LO; PG8_SCHED;
            PG8_LDB(B1, B18, 0, 1); PG8_STAGE(PG8_SB(0, 0), b2, voffB);
            PG8_BAR; PG8_HI; PG8_WAIT_L(0); PG8_MMA(0, 1, B1, B18); PG8_BAR; PG8_LO;
            PG8_LDA(0, 1); PG8_STAGE(PG8_SA(0, 0), a2, voffA);
            PG8_BAR; PG8_HI; PG8_WAIT_L(0); PG8_MMA(1, 0, B0, B08); PG8_BAR; PG8_LO; PG8_SCHED;
            PG8_STAGE(PG8_SB(0, 1), b2 + hstep, voffB);
            PG8_WAIT_V(6); PG8_BAR; PG8_HI; PG8_MMA(1, 1, B1, B18); PG8_BAR; PG8_LO;
            PG8_LDB(B0, B08, 1, 0); PG8_SCHED; PG8_LDA(1, 0); PG8_STAGE(PG8_SA(0, 1), a2 + hstep, voffA);
            PG8_WAIT_L(8); PG8_BAR; PG8_HI; PG8_WAIT_L(0); PG8_MMA(0, 0, B0, B08); PG8_BAR; PG8_LO; PG8_SCHED;
            PG8_LDB(B1, B18, 1, 1); PG8_STAGE(PG8_SB(1, 0), b3, voffB);
            PG8_BAR; PG8_HI; PG8_WAIT_L(0); PG8_MMA(0, 1, B1, B18); PG8_BAR; PG8_LO;
            PG8_LDA(1, 1); PG8_STAGE(PG8_SA(1, 0), a3, voffA);
            PG8_BAR; PG8_HI; PG8_WAIT_L(0); PG8_MMA(1, 0, B0, B08); PG8_BAR; PG8_LO; PG8_SCHED;
            PG8_STAGE(PG8_SB(1, 1), b3 + hstep, voffB);
            PG8_WAIT_V(6); PG8_BAR; PG8_HI; PG8_MMA(1, 1, B1, B18); PG8_BAR; PG8_LO;
        }
        { int l_; asm volatile("v_mbcnt_lo_u32_b32 %0, -1, 0\n\tv_mbcnt_hi_u32_b32 %0, -1, %0" : "=v"(l_));
          E(acc, cur, wr, wc, l_ & 15, l_ >> 4); }
        if (!has_next) break;
#pragma unroll
        for (int a = 0; a < 2; ++a)
#pragma unroll
            for (int b = 0; b < 2; ++b)
#pragma unroll
                for (int m = 0; m < 4; ++m)
#pragma unroll
                    for (int n = 0; n < 2; ++n) acc[a][b][m][n] = (f32x4){0.f, 0.f, 0.f, 0.f};
        cur = nxt; cA = nA; cB = nB; ++ui;
    }
    PG8_WAIT_V(0);
    if (wr == 0) PG8_BAR;
    PG8_BAR;
#undef PG8_SA
#undef PG8_SB
#undef PG8_STAGE
#undef PG8_LDA
#undef PG8_LDB
#undef PG8_MMA
#undef PG8_CAT8
#undef PG8_LD16
#undef PG8_WAIT_V
#undef PG8_WAIT_L
#undef PG8_BAR
#undef PG8_SCHED
#undef PG8_HI
#undef PG8_LO
}
}


namespace fa {
constexpr int QBLK = 32, KVBLK = 64, QB = 256, D = 128;
constexpr int SHM_V = 16384, SHM_K = 16384, SHM_X = 2048;
constexpr int OFF_V = 0, OFF_K = 2 * SHM_V, OFF_X = OFF_K + 2 * SHM_K, OFF_W = OFF_X + 2 * SHM_X;
constexpr float SCALE = 0.08838834764831845f, THR = 8.f;
typedef short s16x4 __attribute__((ext_vector_type(4)));
#define KSWZ(row, colB) ((row) * 256 + ((colB) ^ (((row) & 7) << 4)))
#define SBAR() __builtin_amdgcn_sched_barrier(0)
__device__ __forceinline__ int v_st(int k, int c) { const int kk = (k & ~0xC) | ((k & 4) << 1) | ((k & 8) >> 1); return ((kk >> 3) * 4 + (c >> 5)) * 512 + ((kk & 7) * 32 + (c & 31)) * 2; }
__device__ __forceinline__ int v_rd_base(int lane) { return ((lane & 3) << 3) | (((lane >> 2) & 3) << 6) | (((lane >> 4) & 1) << 5) | (((lane >> 5) & 1) << 8); }
constexpr int v_rd_off(int d0, int ks, int half) { return d0 * 512 + ks * 4096 + half * 2048; }
__device__ __forceinline__ int crow(int r, int hi) { return (r & 3) + 8 * (r >> 2) + 4 * hi; }
__device__ __forceinline__ void mask_causal(f32x16& p0, f32x16& p1, int dq) {
    const float NEG = -__builtin_inff();
#pragma unroll
    for (int r = 0; r < 16; ++r) { const int c = (r & 3) + 8 * (r >> 2); if (dq - c < 0) p0[r] = NEG; if (dq - c - 32 < 0) p1[r] = NEG; }
}
__device__ __forceinline__ void mask_bits(f32x16& p0, f32x16& p1, unsigned long long mw, int hi) {
    const unsigned lo = (unsigned)mw >> (4 * hi), hw = (unsigned)(mw >> 32) >> (4 * hi);
#pragma unroll
    for (int r = 0; r < 16; ++r) { const int c = (r & 3) + 8 * (r >> 2);
        const unsigned t0 = (unsigned)((int)(lo << (31 - c)) >> 31), t1 = (unsigned)((int)(hw << (31 - c)) >> 31);
        p0[r] = __uint_as_float(__builtin_amdgcn_bitop3_b32(__float_as_uint(p0[r]), 0xFF800000u, t0, 0xe4));
        p1[r] = __uint_as_float(__builtin_amdgcn_bitop3_b32(__float_as_uint(p1[r]), 0xFF800000u, t1, 0xe4)); }
}
__device__ __forceinline__ void partialSM(f32x16& p0, f32x16& p1, float& m_reg, float& mn, float& alpha) {
    float pmax = p0[0]; for (int r = 1; r < 16; ++r) pmax = fmaxf(pmax, p0[r]); for (int r = 0; r < 16; ++r) pmax = fmaxf(pmax, p1[r]);
    { auto rr = __builtin_amdgcn_permlane32_swap(__float_as_uint(pmax), __float_as_uint(pmax), false, false);
      pmax = fmaxf(__uint_as_float(rr[0]), __uint_as_float(rr[1])); }
    constexpr float C2 = 1.4426950408889634f * SCALE;
    if (__builtin_expect(__all((pmax - m_reg) * SCALE <= THR), 1)) { mn = m_reg; alpha = 1.f; }
    else { mn = fmaxf(m_reg, pmax); alpha = __builtin_amdgcn_exp2f((m_reg - mn) * C2); m_reg = mn; }
    const float mnL = -mn * C2;
    for (int r = 0; r < 16; ++r) p0[r] = fmaf(p0[r], C2, mnL); for (int r = 0; r < 16; ++r) p1[r] = fmaf(p1[r], C2, mnL);
    for (int r = 0; r < 16; ++r) p0[r] = __builtin_amdgcn_exp2f(p0[r]);
}
__device__ __forceinline__ void finishSM(f32x16& p0, f32x16& p1, float alpha, float& l_reg, bf16x8& pa0, bf16x8& pa1, bf16x8& pa2, bf16x8& pa3) {
    for (int r = 0; r < 16; ++r) p1[r] = __builtin_amdgcn_exp2f(p1[r]);
    float ps = 0; for (int r = 0; r < 16; ++r) ps += p0[r]; for (int r = 0; r < 16; ++r) ps += p1[r];
    { auto rr = __builtin_amdgcn_permlane32_swap(__float_as_uint(ps), __float_as_uint(ps), false, false);
      ps = __uint_as_float(rr[0]) + __uint_as_float(rr[1]); }
    l_reg = l_reg * alpha + ps;
#define PK4(P, B_, OUT) do { unsigned a0 = cvt_pk_bf16(P[B_+0], P[B_+1]), a1 = cvt_pk_bf16(P[B_+2], P[B_+3]);                          \
        unsigned b0 = cvt_pk_bf16(P[B_+4], P[B_+5]), b1 = cvt_pk_bf16(P[B_+6], P[B_+7]);                                             \
        auto r0 = __builtin_amdgcn_permlane32_swap(a0, b0, false, false); auto r1 = __builtin_amdgcn_permlane32_swap(a1, b1, false, false); \
        u32x4 w = {r0[0], r1[0], r0[1], r1[1]}; OUT = *reinterpret_cast<bf16x8*>(&w); } while (0)
    PK4(p0, 0, pa0); PK4(p0, 8, pa1); PK4(p1, 0, pa2); PK4(p1, 8, pa3);
#undef PK4
}
template <int KB, bool EXT>
__device__ __forceinline__ void qkt(f32x16& p0, f32x16& p1, const char* lds, int r32, int hi, const bf16x8* qr, bf16x8 qx) {
    p0 = f32x16{}; p1 = f32x16{};
    const char* kb[4];
#pragma unroll
    for (int dd = 0; dd < 4; ++dd) kb[dd] = lds + OFF_K + KB * SHM_K + KSWZ(r32, (dd * 16 + hi * 8) * 2);
#pragma unroll
    for (int d0 = 0; d0 < 8; ++d0) { const char* a = kb[d0 & 3] + (d0 >> 2) * 128;
        bf16x8 b0 = *reinterpret_cast<const bf16x8*>(a);
        bf16x8 b1 = *reinterpret_cast<const bf16x8*>(a + 32 * 256);
        p0 = __builtin_amdgcn_mfma_f32_32x32x16_bf16(b0, qr[d0], p0, 0, 0, 0);
        p1 = __builtin_amdgcn_mfma_f32_32x32x16_bf16(b1, qr[d0], p1, 0, 0, 0); }
    if (EXT) { const char* xa = lds + OFF_X + KB * SHM_X + r32 * 32 + hi * 16;
        bf16x8 x0 = *reinterpret_cast<const bf16x8*>(xa), x1 = *reinterpret_cast<const bf16x8*>(xa + 32 * 32);
        p0 = __builtin_amdgcn_mfma_f32_32x32x16_bf16(x0, qx, p0, 0, 0, 0);
        p1 = __builtin_amdgcn_mfma_f32_32x32x16_bf16(x1, qx, p1, 0, 0, 0); }
}
template <int VB>
__device__ __forceinline__ void pv_tile(f32x16* o, int vb0, bf16x8 pa0, bf16x8 pa1, bf16x8 pa2, bf16x8 pa3) {
#define TRRD(dst, off) asm volatile("ds_read_b64_tr_b16 %0, %1 offset:%2" : "=&v"(dst) : "v"(vb0), "i"(off) : "memory")
#define PV_D0(d0) do { s16x4 l0, l1, l2, l3, h0, h1, h2, h3; constexpr int b_ = OFF_V + VB * SHM_V + v_rd_off(d0, 0, 0); \
        TRRD(l0, b_); TRRD(h0, b_ + 2048); TRRD(l1, b_ + 4096); TRRD(h1, b_ + 6144); TRRD(l2, b_ + 8192); TRRD(h2, b_ + 10240); TRRD(l3, b_ + 12288); TRRD(h3, b_ + 14336); \
        asm volatile("s_waitcnt lgkmcnt(0)" ::: "memory"); SBAR();   \
        o[d0] = __builtin_amdgcn_mfma_f32_32x32x16_bf16(pa0, (bf16x8){l0[0], l0[1], l0[2], l0[3], h0[0], h0[1], h0[2], h0[3]}, o[d0], 0, 0, 0);   \
        o[d0] = __builtin_amdgcn_mfma_f32_32x32x16_bf16(pa1, (bf16x8){l1[0], l1[1], l1[2], l1[3], h1[0], h1[1], h1[2], h1[3]}, o[d0], 0, 0, 0);   \
        o[d0] = __builtin_amdgcn_mfma_f32_32x32x16_bf16(pa2, (bf16x8){l2[0], l2[1], l2[2], l2[3], h2[0], h2[1], h2[2], h2[3]}, o[d0], 0, 0, 0);   \
        o[d0] = __builtin_amdgcn_mfma_f32_32x32x16_bf16(pa3, (bf16x8){l3[0], l3[1], l3[2], l3[3], h3[0], h3[1], h3[2], h3[3]}, o[d0], 0, 0, 0); } while (0)
    PV_D0(0); PV_D0(1); PV_D0(2); PV_D0(3);
#undef PV_D0
#undef TRRD
}
template <int MODE>
__device__ __forceinline__ void attn_block(char* lds, const bf16_t* Qh  , const float* qgain, const float* rot, const bf16_t* Kh, const bf16_t* Vh, const bf16_t* QXh, const bf16_t* KXh,
                                           const unsigned long long* mrow, const bf16_t* gate, bf16_t* Ob, int ocol0, int hoff, int P0,
                                           int jb, int je, float* part, float* pml) {
    int lane; asm volatile("v_mbcnt_lo_u32_b32 %0, -1, 0\n\tv_mbcnt_hi_u32_b32 %0, -1, %0" : "=v"(lane));
    const int wid = __builtin_amdgcn_readfirstlane(threadIdx.x >> 6), tid = wid * 64 + lane, r32 = lane & 31, hi = lane >> 5;
    const int qlo = P0 + wid * QBLK, qm = qlo + r32 - 4 * hi, lastj = qlo / KVBLK;
    float* wsw = (float*)(lds + OFF_W) + wid * 64; float* li_l = wsw; float* al_l = wsw + 32;
    const int vb0 = (int)(uintptr_t)lds + v_rd_base(lane);
    const unsigned ldsb = (unsigned)(uintptr_t)lds;
    bf16x8 qr[8];
    { const bf16_t* qrow = Qh + (size_t)(qlo + r32) * NINP + hi * 8; float qv[8][8]; float ss = 0.f;
#pragma unroll
      for (int d0 = 0; d0 < 8; ++d0) { const u32x4 w = *reinterpret_cast<const u32x4*>(qrow + d0 * 16);
          qv[d0][0] = bf_lo(w.x); qv[d0][1] = bf_hi(w.x); qv[d0][2] = bf_lo(w.y); qv[d0][3] = bf_hi(w.y); qv[d0][4] = bf_lo(w.z); qv[d0][5] = bf_hi(w.z); qv[d0][6] = bf_lo(w.w); qv[d0][7] = bf_hi(w.w);
#pragma unroll
          for (int j = 0; j < 8; ++j) ss = fmaf(qv[d0][j], qv[d0][j], ss); }
      { auto rr = __builtin_amdgcn_permlane32_swap(__float_as_uint(ss), __float_as_uint(ss), false, false); ss = __uint_as_float(rr[0]) + __uint_as_float(rr[1]); }
      const float rstd = 1.f / sqrtf(ss * (1.f / HD) + RMS_EPS);
#pragma unroll
      for (int d0 = 0; d0 < 8; ++d0) { const f32x4 g0 = *(const f32x4*)(qgain + d0 * 16 + hi * 8), g1 = *(const f32x4*)(qgain + d0 * 16 + hi * 8 + 4);
#pragma unroll
          for (int j = 0; j < 4; ++j) { qv[d0][j] *= rstd * g0[j]; qv[d0][4 + j] *= rstd * g1[j]; } }
      if (MODE == 0) { const float* rp = rot + ((size_t)(qlo + r32) * 16 + hi * 8) * 2;
#pragma unroll
          for (int j = 0; j < 8; j += 2) { const f32x4 cs = *(const f32x4*)(rp + 2 * j);
              { const float x1 = qv[0][j], x2 = qv[1][j]; qv[0][j] = x1 * cs[0] - x2 * cs[1]; qv[1][j] = x2 * cs[0] + x1 * cs[1]; }
              { const float x1 = qv[0][j + 1], x2 = qv[1][j + 1]; qv[0][j + 1] = x1 * cs[2] - x2 * cs[3]; qv[1][j + 1] = x2 * cs[2] + x1 * cs[3]; } } }
#pragma unroll
      for (int d0 = 0; d0 < 8; ++d0) { u32x4 w; w.x = cvt_pk_bf16(qv[d0][0], qv[d0][1]); w.y = cvt_pk_bf16(qv[d0][2], qv[d0][3]); w.z = cvt_pk_bf16(qv[d0][4], qv[d0][5]); w.w = cvt_pk_bf16(qv[d0][6], qv[d0][7]);
          qr[d0] = *reinterpret_cast<bf16x8*>(&w); } }
    bf16x8 qx = (bf16x8){0, 0, 0, 0, 0, 0, 0, 0};
    if (MODE == 1 && hi == 0) qx = *reinterpret_cast<const bf16x8*>(QXh + (size_t)(qlo + r32) * 8);
    unsigned koff[2], voff[2];
#pragma unroll
    for (int i = 0; i < 2; ++i) { const int q = tid * 16 + i * 8192;
        { const int row = q >> 8, colB = (q & 255) ^ ((row & 7) << 4); koff[i] = (unsigned)(row * 256 + colB); }
        { const int sb = q >> 9, w = q & 511, kk = (sb >> 2) * 8 + (w >> 6), k = (kk & ~0xC) | ((kk & 4) << 1) | ((kk & 8) >> 1), col = (sb & 3) * 32 + ((w & 63) >> 4) * 8; voff[i] = (unsigned)(k * 256 + col * 2); } }
#define KDMA(k0, bf) do { const bf16_t* kb_ = Kh + (size_t)(k0) * D; _Pragma("unroll") for (int i_ = 0; i_ < 2; ++i_) pg8::glds16_s((const void*)kb_, koff[i_], ldsb + OFF_K + (bf) * SHM_K + wid * 1024 + i_ * 8192); } while (0)
#define VDMA(k0, bf) do { const bf16_t* vb_ = Vh + (size_t)(k0) * D; _Pragma("unroll") for (int i_ = 0; i_ < 2; ++i_) pg8::glds16_s((const void*)vb_, voff[i_], ldsb + OFF_V + (bf) * SHM_V + wid * 1024 + i_ * 8192); } while (0)
    const unsigned mo = (unsigned)(qlo + r32) * 1024u;
#define MLOAD(t_) (*(const unsigned long long*)((const char*)(mrow + (t_)) + mo))
    float m_reg = -1e30f, l_reg = 0.f; f32x16 o[4] = {};
#define RESC(a) do { if (__any((a) < 1.f)) { if (hi == 0) al_l[r32] = (a); asm volatile("s_waitcnt lgkmcnt(0)" ::: "memory");              \
                     for (int d_ = 0; d_ < 4; ++d_) for (int r = 0; r < 16; ++r) o[d_][r] *= al_l[crow(r, hi)]; } } while (0)
    __syncthreads();
    if constexpr (MODE == 0) {
#define ACT(t) ((t) <= lastj)
        unsigned long long mw;
        f32x16 pA0, pA1, pB0, pB1; float mnA = 0.f, mnB = 0.f, alA = 1.f, alB = 1.f; bf16x8 pa0, pa1, pa2, pa3;
        const int NTr = je - jb;
        KDMA(jb * KVBLK, 0); VM_WAIT(); __syncthreads();
        mw = MLOAD(jb); KDMA((jb + 1) * KVBLK, 1); VDMA(jb * KVBLK, 0);
        if (ACT(jb)) { qkt<0, false>(pA0, pA1, lds, r32, hi, qr, qx); mask_bits(pA0, pA1, mw, hi); partialSM(pA0, pA1, m_reg, mnA, alA); }
        VM_WAIT(); __syncthreads();
#define HALF(PX0, PX1, mnX, alX, PY0, PY1, alY, t, KB, VB) do { \
        mw = MLOAD(t); if ((t) + 1 < je) KDMA(((t) + 1) * KVBLK, (KB) ^ 1); VDMA((t) * KVBLK, KB); \
        SBAR(); if (ACT(t)) qkt<KB, false>(PX0, PX1, lds, r32, hi, qr, qx); \
        if (ACT((t) - 1)) finishSM(PY0, PY1, alY, l_reg, pa0, pa1, pa2, pa3); SBAR(); \
        if (ACT((t) - 1)) pv_tile<VB>(o, vb0, pa0, pa1, pa2, pa3); \
        if (ACT(t)) { mask_bits(PX0, PX1, mw, hi); partialSM(PX0, PX1, m_reg, mnX, alX); RESC(alX); } \
        VM_WAIT(); __syncthreads(); } while (0)
#define HALFU(PX0, PX1, mnX, alX, PY0, PY1, alY, t, KB, VB) do { \
        mw = MLOAD(t); if ((t) + 1 < je) KDMA(((t) + 1) * KVBLK, (KB) ^ 1); VDMA((t) * KVBLK, KB); \
        SBAR(); qkt<KB, false>(PX0, PX1, lds, r32, hi, qr, qx); \
        finishSM(PY0, PY1, alY, l_reg, pa0, pa1, pa2, pa3); SBAR(); \
        pv_tile<VB>(o, vb0, pa0, pa1, pa2, pa3); \
        mask_bits(PX0, PX1, mw, hi); partialSM(PX0, PX1, m_reg, mnX, alX); RESC(alX); \
        VM_WAIT(); __syncthreads(); } while (0)
        const int tdiag = P0 / KVBLK; int r = 1;
        for (; r + 1 < NTr && jb + r + 1 <= tdiag; r += 2) {
            HALFU(pB0, pB1, mnB, alB, pA0, pA1, alA, jb + r, 1, 0);
            HALFU(pA0, pA1, mnA, alA, pB0, pB1, alB, jb + r + 1, 0, 1);
        }
        for (; r + 1 < NTr; r += 2) {
            HALF(pB0, pB1, mnB, alB, pA0, pA1, alA, jb + r, 1, 0);
            HALF(pA0, pA1, mnA, alA, pB0, pB1, alB, jb + r + 1, 0, 1);
        }
#undef HALFU
        HALF(pB0, pB1, mnB, alB, pA0, pA1, alA, je - 1, 1, 0);
        if (ACT(je - 1)) { finishSM(pB0, pB1, alB, l_reg, pa0, pa1, pa2, pa3); SBAR(); pv_tile<1>(o, vb0, pa0, pa1, pa2, pa3); }
#undef HALF
#undef ACT
    } else {
        bf16x8 st_x = (bf16x8){0, 0, 0, 0, 0, 0, 0, 0};
        const int xkey = tid >> 1, xhalf = tid & 1; const unsigned xo = (unsigned)xkey * 16u;
#define XLOAD(k0) do { if (tid < 128 && xhalf == 0) st_x = *reinterpret_cast<const bf16x8*>((const char*)(KXh + (size_t)(k0) * 8) + xo); } while (0)
#define XWRITE(bf) do { if (tid < 128) *(bf16x8*)(lds + OFF_X + (bf) * SHM_X + xkey * 32 + xhalf * 16) = st_x; } while (0)
        KDMA(jb * KVBLK, 0); VDMA(jb * KVBLK, 0); XLOAD(jb * KVBLK); VM_WAIT(); XWRITE(0); __syncthreads();
#define STEP(t, BUF) do { \
        if ((t) + 1 < je) { KDMA(((t) + 1) * KVBLK, (BUF) ^ 1); VDMA(((t) + 1) * KVBLK, (BUF) ^ 1); XLOAD(((t) + 1) * KVBLK); } \
        if ((t) <= lastj) { f32x16 p0, p1; float mn, al; bf16x8 pa0, pa1, pa2, pa3; \
            qkt<BUF, true>(p0, p1, lds, r32, hi, qr, qx); \
            if ((t) == lastj) mask_causal(p0, p1, qm - (t) * KVBLK); \
            partialSM(p0, p1, m_reg, mn, al); RESC(al); finishSM(p0, p1, al, l_reg, pa0, pa1, pa2, pa3); SBAR(); \
            pv_tile<BUF>(o, vb0, pa0, pa1, pa2, pa3); } \
        VM_WAIT(); if ((t) + 1 < je) XWRITE((BUF) ^ 1); \
        __syncthreads(); } while (0)
        for (int t = jb; t < je; t += 2) { STEP(t, 0); STEP(t + 1, 1); }
#undef STEP
#undef XLOAD
#undef XWRITE
    }
#undef RESC
#undef KDMA
#undef VDMA
#undef MLOAD
    if (part) {
        if (hi == 0) { pml[(wid * QBLK + r32) * 2] = m_reg; pml[(wid * QBLK + r32) * 2 + 1] = l_reg; }
#pragma unroll
        for (int r = 0; r < 16; ++r)
#pragma unroll
            for (int d0 = 0; d0 < 4; ++d0) part[(size_t)(wid * QBLK + crow(r, hi)) * D + d0 * 32 + r32] = o[d0][r];
        return;
    }
    if (hi == 0) li_l[r32] = l_reg; asm volatile("s_waitcnt lgkmcnt(0)" ::: "memory");
#pragma unroll
    for (int r = 0; r < 16; ++r) { const int orow = qlo + crow(r, hi); const float rl = __builtin_amdgcn_rcpf(li_l[crow(r, hi)]);
#pragma unroll
        for (int d0 = 0; d0 < 4; ++d0) { float v = o[d0][r] * rl; float vn = __shfl_xor(v, 1);
            if ((r32 & 1) == 0) { const int col = d0 * 32 + r32;
                if (MODE == 1) { const unsigned g = *(const unsigned*)(gate + (size_t)orow * 1024 + hoff + col); v *= bf_lo(g); vn *= bf_hi(g); }
                *(unsigned*)(Ob + (size_t)orow * DM + ocol0 + col) = cvt_pk_bf16(v, vn); } } }
}
#undef KSWZ
#undef SBAR
}

__device__ const unsigned short DSA_TAB[48] = {15, 287, 543, 286, 542, 14, 285, 541, 284, 540, 13, 283, 539, 282, 538, 12, 281, 537, 280, 536, 11, 279, 535, 278, 534, 10, 277, 533, 276, 532, 9, 275, 531, 274, 530, 8, 273, 529, 272, 528, 7, 6, 5, 4, 3, 2, 1, 0};

constexpr int MOE_NB_GU = 8 * 224 * 8, MOE_NB_DN = 8 * 32 * 28, MOE_NB = MOE_NB_GU + MOE_NB_DN;
__device__ __forceinline__ void moe_cvt_batch(const float* wg, const float* wu, const float* wd, unsigned char* ws, int b, int wave, int lane) {
    const float* sp; size_t ld; unsigned char* dp;
    if (b < MOE_NB_GU) { const int e = b / 1792, rr = b % 1792, nb = rr >> 3, kb = rr & 7, k0 = 256 * kb + 32 * wave, n0 = 64 * nb; const int tile = n0 >> 8, within = n0 & 255;
        sp = ((within < 128) ? wg : wu) + (size_t)e * DM * DFFE + (size_t)k0 * DFFE + tile * 128 + (within & 127) + lane; ld = DFFE;
        dp = (ws + WS_MWGU) + (size_t)e * 14336 * DM + (size_t)(n0 + lane) * DM + k0; }
    else { const int r = b - MOE_NB_GU; const int e = r / 896, rr = r % 896, nb = rr / 28, kb = rr % 28, k0 = 256 * kb + 32 * wave, n0 = 64 * nb;
        sp = wd + (size_t)e * DFFE * DM + (size_t)k0 * DM + n0 + lane; ld = DM; dp = (ws + WS_MWDN) + (size_t)e * DM * DFFE + (size_t)(n0 + lane) * DFFE + k0; }
    float v[32];
#pragma unroll
    for (int i = 0; i < 32; ++i) v[i] = __builtin_nontemporal_load(sp + (size_t)i * ld) * F8_WSCALE;
#pragma unroll
    for (int c = 0; c < 2; ++c) { u32x4 o; o.x = pk4_fp8(v[16 * c], v[16 * c + 1], v[16 * c + 2], v[16 * c + 3]); o.y = pk4_fp8(v[16 * c + 4], v[16 * c + 5], v[16 * c + 6], v[16 * c + 7]);
        o.z = pk4_fp8(v[16 * c + 8], v[16 * c + 9], v[16 * c + 10], v[16 * c + 11]); o.w = pk4_fp8(v[16 * c + 12], v[16 * c + 13], v[16 * c + 14], v[16 * c + 15]);
        *(u32x4*)(dp + 16 * c) = o; }
}
template <int NPULL>
__device__ __forceinline__ void xcd_barrier_fill(const XcdBarrier& b, volatile LAS unsigned* fs, unsigned* qctr, const float* wg, const float* wu, const float* wd, unsigned char* ws, int tid, int wave, int lane) {
    asm volatile("s_waitcnt vmcnt(0)" ::: "memory");
    __syncthreads();
    if (tid == 0) {
        unsigned* bar = b.bar;
        __builtin_amdgcn_s_waitcnt(0);
        unsigned nloc = b.st[0], nx = b.st[1];
        if (nloc == 0u) { xcd_barrier_complete(bar, b.x, nloc, nx); b.st[0] = nloc; b.st[1] = nx; }
        const unsigned old = xb_add(&bar[XB_XSUB(b.x)], 1u);
        const unsigned gen = old / nloc;
        if (old + 1u == (gen + 1u) * nloc) {
            __builtin_amdgcn_fence(__ATOMIC_RELEASE, "agent");
            asm volatile("s_waitcnt vmcnt(0)" ::: "memory");
            const unsigned og = xb_add(&bar[XB_TOP], 1u);
            const unsigned tg = og / nx;
            if (og + 1u == (tg + 1u) * nx) xb_add(&bar[XB_TOPGEN], 1u);
            else XB_SPIN(xb_ld(&bar[XB_TOPGEN]) == tg, bar);
            __builtin_amdgcn_fence(__ATOMIC_ACQUIRE, "agent");
            xb_add(&bar[XB_XGEN(b.x)], 1u);
            asm volatile("s_waitcnt vmcnt(0)" ::: "memory");
            fs[0] = 1u;
        } else { fs[0] = 0u; fs[1] = gen; }
    }
    __syncthreads();
    if (fs[0] == 0u) {
        const unsigned gen = fs[1];
        for (;;) {
            if (tid == 0) { const unsigned rel = (xb_ld(&b.bar[XB_XGEN(b.x)]) != gen) ? 1u : 0u; fs[2] = rel;
                fs[3] = rel ? 0u : __hip_atomic_fetch_add(qctr, (unsigned)NPULL, __ATOMIC_RELAXED, __HIP_MEMORY_SCOPE_AGENT); }
            __syncthreads();
            const unsigned rel = fs[2], bt = fs[3];
            if (rel) break;
            if (bt >= (unsigned)MOE_NB) {
                if (tid == 0) XB_SPIN(xb_ld(&b.bar[XB_XGEN(b.x)]) == gen, b.bar);
                break; }
#pragma unroll
            for (int q = 0; q < NPULL; ++q) if (bt + q < (unsigned)MOE_NB) moe_cvt_batch(wg, wu, wd, ws, (int)(bt + q), wave, lane);
            __syncthreads();
        }
        if (tid == 0) { __builtin_amdgcn_fence(__ATOMIC_ACQUIRE, "agent"); asm volatile("s_waitcnt vmcnt(0)" ::: "memory"); }
    }
    __syncthreads();
}

struct Args { const float* in[21]; float* out; unsigned char* ws; int ph_lo, ph_hi; };

struct Frame {
    LAS unsigned char* lds;
    int tid, lane, wave, vcu, G;
    unsigned char* ws;
};

__device__ __forceinline__ void tr_item(const float* srcp, size_t ldsrc, bf16_t* dst, size_t ldd, LAS float* scr, int lane) {
    const int c = lane & 31;
#pragma unroll 8
    for (int i = 0; i < 32; ++i) { const int kk = 2 * i + (lane >> 5); scr[kk * 33 + c] = srcp ? srcp[(size_t)kk * ldsrc] : 0.f; }
    LDS_WAIT();
    const int ch = lane & 7;
#pragma unroll
    for (int j = 0; j < 4; ++j) { const int n = (lane >> 3) + 8 * j; const LAS float* s = scr + (8 * ch) * 33 + n;
        u32x4 o; o.x = cvt_pk_bf16(s[0 * 33], s[1 * 33]); o.y = cvt_pk_bf16(s[2 * 33], s[3 * 33]); o.z = cvt_pk_bf16(s[4 * 33], s[5 * 33]); o.w = cvt_pk_bf16(s[6 * 33], s[7 * 33]);
        *(u32x4*)(dst + (size_t)n * ldd + 8 * ch) = o; }
    LDS_WAIT();
}
__device__ __forceinline__ int map_in(int n) {
    if (n < 4096) return n;
    if (n < 7168) return 4176 + (n - 4096);
    if (n < 8192) return 7256 + (n - 7168);
    if (n < 8256) return 4096 + (n - 8192);
    if (n < 8272) return 4160 + (n - 8256);
    if (n < 8280) return 7248 + (n - 8272);
    return -1;
}
__device__ __forceinline__ void rms_row_to_bf16(const float* xrow, const float* gain, bf16_t* orow, int lane) {
    const f32x4* xr = (const f32x4*)xrow + lane; const f32x4* gr = (const f32x4*)gain + lane;
    f32x4 v[8]; float s = 0.f;
#pragma unroll
    for (int j = 0; j < 8; ++j) { v[j] = xr[64 * j]; s += (v[j].x * v[j].x + v[j].y * v[j].y) + (v[j].z * v[j].z + v[j].w * v[j].w); }
    const float rstd = 1.f / sqrtf(wave_sum(s) * (1.f / DM) + RMS_EPS);
    u32x2* o8 = (u32x2*)orow + lane;
#pragma unroll
    for (int j = 0; j < 8; ++j) { const f32x4 g = gr[64 * j]; u32x2 w; w.x = cvt_pk_bf16(v[j].x * rstd * g.x, v[j].y * rstd * g.y); w.y = cvt_pk_bf16(v[j].z * rstd * g.z, v[j].w * rstd * g.w); o8[64 * j] = w; }
}

__global__ void __launch_bounds__(NTHREADS, 2) mega_fwd(Args args) {
    extern __shared__ __attribute__((aligned(16))) unsigned char lds_raw[];
    Frame F;
    F.lds = (LAS unsigned char*)lds_raw;
    F.tid = threadIdx.x; F.lane = F.tid & 63; F.wave = __builtin_amdgcn_readfirstlane(F.tid >> 6);
    F.G = gridDim.x; { const int bx = blockIdx.x; F.vcu = (F.G % 8 == 0) ? (bx % 8) * (F.G / 8) + bx / 8 : bx; }
    F.ws = args.ws;
    unsigned char* ws = args.ws;
    int tid = F.tid, lane = F.lane; const int wave = F.wave;
    const int gw = F.vcu * NWAVES + wave, NGW = F.G * NWAVES;
    volatile LAS unsigned* MISC = (volatile LAS unsigned*)(F.lds + MISC_OFF);
#if MK_FUSED
    for (int u = tid; u < (LDS_BYTES - RING_BYTES) / 4; u += NTHREADS) ((LAS unsigned*)(F.lds + RING_BYTES))[u] = 0u;
    __syncthreads();
    XcdBarrier bar = xcd_barrier_post((unsigned*)(ws + WS_CTL) + CW_BAR, MISC + 8);
    if (tid == 0) { MISC[20] = __hip_atomic_fetch_add((unsigned*)(ws + WS_CTL) + 3200 + 64 * (bar.x & 7u), 1u, __ATOMIC_RELAXED, __HIP_MEMORY_SCOPE_AGENT); MISC[21] = bar.x; }
#define GRID_BAR() xcd_barrier(bar)
#else
    (void)MISC;
#define GRID_BAR() do { } while (0)
#endif
    const int lo = args.ph_lo, hi = args.ph_hi;
    int gcid = (int)blockIdx.x;
#ifndef MK_PHASE_MASK
#define MK_PHASE_MASK 0x3ffff
#endif
#define IN(k) (((MK_PHASE_MASK >> (k)) & 1) && lo <= (k) && (k) < hi)
#define PHASE(k) if (IN(k))
#if MK_FUSED
#define SEAM(k) do { if (IN(k) && IN((k) + 1)) { if ((k) <= 14) xcd_barrier_fill<1>(bar, MISC + 12, (unsigned*)(ws + WS_CTL) + 3072, args.in[18], args.in[19], args.in[20], ws, tid, wave, lane); else xcd_barrier(bar); } } while (0)
#else
#define SEAM(k) do { } while (0)
#endif

#define WIN ((bf16_t*)(ws + WS_WIN))
#define WOUT ((bf16_t*)(ws + WS_WOUT))
#define WGU ((bf16_t*)(ws + WS_WGU))
#define WDN ((bf16_t*)(ws + WS_WDN))
#define WPOOL ((bf16_t*)(ws + WS_WPOOL))
#define MWGU8 ((unsigned char*)(ws + WS_MWGU))
#define MWDN8 ((unsigned char*)(ws + WS_MWDN))
#define SCORES ((float*)(ws + WS_BIG1))
#define ACT ((bf16_t*)(ws + WS_BIG1))
#define ACTM8 ((unsigned char*)(ws + WS_BIG1))
#define PROJ ((bf16_t*)(ws + WS_BIG2))
#define YM ((bf16_t*)(ws + WS_BIG2))
#define YMP ((float*)(ws + WS_YMP))
#define QA ((bf16_t*)(ws + WS_ATT))
#define KA (QA + (size_t)NH * S * HD)
#define VA (QA + (size_t)2 * NH * S * HD)
#define QB (QA + (size_t)3 * NH * S * HD)
#define KB (QA + (size_t)4 * NH * S * HD)
#define VB (QA + (size_t)5 * NH * S * HD)
#define GBG (QA + (size_t)6 * NH * S * HD)
#define QI (GBG + (size_t)S * 1024)
#define HS8 ((unsigned char*)(ws + WS_ATT))
#define MASK ((unsigned long long*)(ws + WS_MASK))
#define OB ((bf16_t*)(ws + WS_O))
#define POOLED ((bf16_t*)(ws + WS_O))
#define HB ((bf16_t*)(ws + WS_H))
#define X1 ((float*)(ws + WS_X1))
#define X3 ((float*)(ws + WS_X1))
#define X2 ((float*)(ws + WS_X2))
#define WI ((float*)(ws + WS_WI))
#define LOGF ((float*)(ws + WS_LOGF))
#define CC ((float*)(ws + WS_CC))
#define TOKE ((unsigned*)(ws + WS_TOKE))
#define TOKG ((f32x2*)(ws + WS_TOKG))
#define RSTD3 ((float*)(ws + WS_RSTD3))
#define SLOT ((u32x2*)(ws + WS_SLOT))
#define CNT ((unsigned*)(ws + WS_CNT))
#define TEXP ((int*)(ws + WS_TEXP))
#define KI ((bf16_t*)(ws + WS_KI))
#define QX ((bf16_t*)(ws + WS_QX))
#define NQB ((float*)(ws + WS_NQB))
#define NKB ((float*)(ws + WS_NKB))
#define JLO ((int*)(ws + WS_JLO))
#define ROT ((float*)(ws + WS_ROT))
#define QLIN ((bf16_t*)(ws + WS_QLIN))
#define PART ((float*)(ws + WS_PART))
#define PML ((float*)(ws + WS_PART + 32 * MiB))
#define KX ((bf16_t*)(ws + WS_KX))
#define x_in (args.in[0])

    PHASE(0) {
        LAS unsigned char* tscr = F.lds + wave * 8192;
        constexpr int I_IN = 132 * 32, I_OUT = 32 * 32, I_GU = 176 * 32, I_DN = 32 * 88, I_PL = 4 * 8 * 8;
        constexpr int NITEMS = I_IN + I_OUT + I_GU + I_DN + I_PL;
        for (int it = gw; it < NITEMS; it += NGW) {
            int r = it; const float* sp; size_t ld, dpitch; bf16_t* dp0;
            if (r < I_IN) { const int kb = r / 132, nb = r % 132, k0 = 64 * kb, n0 = 64 * nb; const int scn = map_in(n0 + lane);
                sp = scn >= 0 ? args.in[2] + (size_t)k0 * 8280 + scn : nullptr; ld = 8280; dp0 = WIN + (size_t)n0 * DM + k0; dpitch = DM * 2; }
            else if ((r -= I_IN) < I_OUT) { const int kb = r / 32, nb = r % 32, k0 = 64 * kb, n0 = 64 * nb;
                sp = args.in[8] + (size_t)k0 * DM + n0 + lane; ld = DM; dp0 = WOUT + (size_t)n0 * DM + k0; dpitch = DM * 2; }
            else if ((r -= I_OUT) < I_GU) { const int kb = r / 176, nb = r % 176, k0 = 64 * kb, n0 = 64 * nb; const int tile = n0 >> 8, within = n0 & 255;
                sp = ((within < 128) ? args.in[10] : args.in[11]) + (size_t)k0 * DFF + tile * 128 + (within & 127) + lane; ld = DFF; dp0 = WGU + (size_t)n0 * DM + k0; dpitch = DM * 2; }
            else if ((r -= I_GU) < I_DN) { const int kb = r / 32, nb = r % 32, k0 = 64 * kb, n0 = 64 * nb;
                sp = args.in[12] + (size_t)k0 * DM + n0 + lane; ld = DM; dp0 = WDN + (size_t)n0 * DFF + k0; dpitch = DFF * 2; }
            else { r -= I_DN; const int g = r / 64, rr = r % 64, kb = rr / 8, nb = rr % 8, k0 = 64 * kb, n0 = 64 * nb;
                sp = args.in[14] + (size_t)g * 512 * 512 + (size_t)k0 * 512 + n0 + lane; ld = 512; dp0 = WPOOL + (size_t)g * 512 * 512 + (size_t)n0 * 512 + k0; dpitch = 512 * 2; }
            float v[64];
#pragma unroll
            for (int i = 0; i < 64; ++i) v[i] = sp ? __builtin_nontemporal_load(sp + (size_t)i * ld) : 0.f;
#pragma unroll
            for (int c8 = 0; c8 < 8; ++c8) { u32x4 o; o.x = cvt_pk_bf16(v[8 * c8], v[8 * c8 + 1]); o.y = cvt_pk_bf16(v[8 * c8 + 2], v[8 * c8 + 3]); o.z = cvt_pk_bf16(v[8 * c8 + 4], v[8 * c8 + 5]); o.w = cvt_pk_bf16(v[8 * c8 + 6], v[8 * c8 + 7]);
                *(LAS u32x4*)(tscr + lane * 128 + ((c8 ^ (lane & 7)) << 4)) = o; }
            LDS_WAIT();
#pragma unroll
            for (int i = 0; i < 8; ++i) { const int row = 8 * i + (lane >> 3), ch = lane & 7;
                *(u32x4*)((char*)dp0 + (size_t)row * dpitch + ch * 16) = *(const LAS u32x4*)(tscr + row * 128 + ((ch ^ (row & 7)) << 4)); }
            LDS_WAIT();
        }
        for (int e_ = gw * 64 + lane; e_ < S * 16; e_ += NGW * 64) {
            const int m = e_ >> 4, i = e_ & 15; const float fm = powf(500000.0f, -(float)i * (1.0f / 16.0f)), am = (float)m * fm; *(f32x2*)(ROT + (size_t)e_ * 2) = (f32x2){cosf(am), sinf(am)}; }
        for (int m = gw; m < S; m += NGW) rms_row_to_bf16(x_in + (size_t)m * DM, args.in[1], HB + (size_t)m * DM, lane);
    }
    SEAM(0);
#if MK_FUSED
    if (IN(0) && IN(1)) {
        if (tid == 0) { unsigned* bw = (unsigned*)(ws + WS_CTL) + CW_BAR; bool ok = (F.G % 8) == 0 && MISC[21] < 8u;
            for (int j = 0; j < 8; ++j) ok = ok && (xb_ld(&bw[XB_XCNT(j)]) == (unsigned)(F.G / 8));
            MISC[22] = ok ? (MISC[20] * 8u + MISC[21]) : (unsigned)blockIdx.x; }
        __syncthreads();
        gcid = __builtin_amdgcn_readfirstlane((int)MISC[22]);
    }
#endif

    PHASE(1) {
        pg8::SchedPlain Sd{(const char*)HB, (const char*)WIN, S / 256, NINP / 256, F.G, gcid, (size_t)256 * DM * 2};
        pg8::EpiInProj E{PROJ, NINP, VA, VB, GBG};
        pg8::gemm_phase(F.lds, DM * 2, DM * 2 / 128, Sd, E);
    }
    SEAM(1);

    PHASE(2) {
        const float* qn_a = args.in[4]; const float* kn_a = args.in[5]; const float* qn_b = args.in[6]; const float* kn_b = args.in[7]; const float* bfor = args.in[3];
        const float ga0 = qn_a[2 * lane], ga1 = qn_a[2 * lane + 1], gk0 = kn_a[2 * lane], gk1 = kn_a[2 * lane + 1];
        const float gb0 = qn_b[2 * lane], gb1 = qn_b[2 * lane + 1], gkb0 = kn_b[2 * lane], gkb1 = kn_b[2 * lane + 1];
        const int TPW = S / NGW;
        unsigned nx[25]; bf16_t nwi, nfb;
#define P2_LOAD(tt) do { const unsigned* pr_ = (const unsigned*)(PROJ + (size_t)(tt) * NINP) + lane; \
            _Pragma("unroll") for (int j_ = 0; j_ < 8; ++j_) { nx[j_] = pr_[64 * (8 + j_)]; nx[8 + j_] = pr_[64 * (24 + j_)]; nx[16 + j_] = pr_[64 * (40 + j_)]; } \
            nx[24] = pr_[64 * 64]; nwi = PROJ[(size_t)(tt) * NINP + C_WI + (lane & 15)]; nfb = PROJ[(size_t)(tt) * NINP + C_FB + (lane & 7)]; } while (0)
        const int t0_ = gw * TPW;
        P2_LOAD(t0_);
        for (int t = t0_; t < t0_ + TPW; ++t) {
            unsigned pv[65];
#pragma unroll
            for (int j = 0; j < 8; ++j) { pv[8 + j] = nx[j]; pv[24 + j] = nx[8 + j]; pv[40 + j] = nx[16 + j]; }
            pv[64] = nx[24]; const bf16_t wi_raw = nwi, fb_raw = nfb;
            const int i0 = 2 * (lane & 7), j0 = 2 * (lane & 3);
            const f32x4 cm = *(const f32x4*)(ROT + ((size_t)t * 16 + i0) * 2);
            const f32x2 ci0 = *(const f32x2*)(ROT + ((size_t)t * 16 + 2 * j0) * 2), ci1 = *(const f32x2*)(ROT + ((size_t)t * 16 + 2 * j0 + 2) * 2);
            const float c0 = cm[0], s0 = cm[1], c1 = cm[2], s1 = cm[3], ic0 = ci0[0], is0 = ci0[1], ic1 = ci1[0], is1 = ci1[1];
            if (t + 1 < t0_ + TPW) P2_LOAD(t + 1);
            const float wsc = bf1(wi_raw) * (1.0f / 32.0f); float qla = 0.f, qlb = 0.f;
#pragma unroll
            for (int h = 0; h < NH; ++h) {
#pragma unroll
                for (int which = 1; which < 2; ++which) {
                    const unsigned w = pv[(which ? 8 : 0) + h];
                    float a = bf_lo(w), b = bf_hi(w);
                    const float r = 1.f / sqrtf(wave_sum(a * a + b * b) * (1.f / HD) + RMS_EPS);
                    a *= r * (which ? gk0 : ga0); b *= r * (which ? gk1 : ga1);
                    const float pa = __shfl_xor(a, 8), pb = __shfl_xor(b, 8);
                    if (lane < 8) { a = a * c0 - pa * s0; b = b * c1 - pb * s1; }
                    else if (lane < 16) { a = a * c0 + pa * s0; b = b * c1 + pb * s1; }
                    ((unsigned*)((which ? KA : QA) + ((size_t)h * S + t) * HD))[lane] = cvt_pk_bf16(a, b);
                }
#pragma unroll
                for (int which = 1; which < 2; ++which) {
                    const unsigned w = pv[(which ? 40 : 32) + h];
                    float a = bf_lo(w), b = bf_hi(w);
                    const float r = 1.f / sqrtf(wave_sum(a * a + b * b) * (1.f / HD) + RMS_EPS);
                    a *= r * (which ? gkb0 : gb0); b *= r * (which ? gkb1 : gb1);
                    { const float n2 = wave_sum(a * a + b * b); if (lane == 0) (which ? NKB : NQB)[(size_t)h * S + t] = n2; }
                    ((unsigned*)((which ? KB : QB) + ((size_t)h * S + t) * HD))[lane] = cvt_pk_bf16(a, b);
                }
                { const unsigned w = pv[24 + h]; float a = bf_lo(w), b = bf_hi(w);
                  const float pa = __shfl_xor(a, 4), pb = __shfl_xor(b, 4); const int l5 = lane & 31;
                  if (l5 < 4) { a = a * ic0 - pa * is0; b = b * ic1 - pb * is1; }
                  else if (l5 < 8) { a = a * ic0 + pa * is0; b = b * ic1 + pb * is1; }
                  const unsigned pk = cvt_pk_bf16(a, b); ((unsigned*)(QI + (size_t)t * 1024 + h * HD))[lane] = pk;
                  const float wv = __shfl(wsc, 2 * h + (lane >> 5)); qla = fmaf(wv, bf_lo(pk), qla); qlb = fmaf(wv, bf_hi(pk), qlb); }
            }
            { const float ta = qla + __shfl_xor(qla, 32), tb = qlb + __shfl_xor(qlb, 32);
              if (lane < 32) ((unsigned*)(QLIN + (size_t)t * IDD))[lane] = cvt_pk_bf16(ta, tb); }
            { const unsigned w = pv[64]; float a = bf_lo(w), b = bf_hi(w);
              const float pa = __shfl_xor(a, 4), pb = __shfl_xor(b, 4); const int l5 = lane & 31;
              if (l5 < 4) { a = a * ic0 - pa * is0; b = b * ic1 - pb * is1; }
              else if (l5 < 8) { a = a * ic0 + pa * is0; b = b * ic1 + pb * is1; }
              if (lane < 32) ((unsigned*)(KI + (size_t)t * IDD))[lane] = cvt_pk_bf16(a, b); }
            if (lane < 16) WI[(size_t)t * 16 + lane] = wsc;
            if (lane < 8) { const float z = bf1(fb_raw) + bfor[lane]; LOGF[(size_t)lane * S + t] = fminf(z, 0.f) - log1pf(__expf(-fabsf(z))); }
        }
    }
#undef P2_LOAD
    SEAM(2);

    PHASE(3) {
        if ((int)blockIdx.x >= F.G - NH) {
            const int h = (int)blockIdx.x - (F.G - NH); LAS double* sd = (LAS double*)F.lds;
            double loc[16]; double s = 0.0;
#pragma unroll
            for (int i = 0; i < 16; ++i) { s += (double)LOGF[(size_t)h * S + tid * 16 + i]; loc[i] = s; }
            sd[tid] = s; __syncthreads();
            if (tid == 0) { double run = 0.0; for (int i = 0; i < NTHREADS; ++i) { const double v = sd[i]; sd[i] = run; run += v; } }
            __syncthreads();
            const double base = sd[tid];
#pragma unroll
            for (int i = 0; i < 16; ++i) CC[(size_t)h * S + tid * 16 + i] = (float)(base + loc[i]);
            LAS float* cend = (LAS float*)(F.lds + 8192); LAS float* cp0 = cend + 128; LAS float* redm = cp0 + 32;
            { float mq = 0.f, mk = 0.f;
              { const float* gq = args.in[6]; for (int i = 0; i < HD; ++i) mq = fmaxf(mq, gq[i] * gq[i]); mq *= (float)HD; }
#pragma unroll
              for (int i = 0; i < 16; ++i) { const int e_ = tid * 16 + i; mk = fmaxf(mk, NKB[(size_t)h * S + e_]);
                  const float cv = (float)(base + loc[i]); if ((e_ & 63) == 63) cend[e_ >> 6] = cv; if ((e_ & 255) == 0) cp0[e_ >> 8] = cv; }
#pragma unroll
              for (int o = 1; o < 64; o <<= 1) { mq = fmaxf(mq, __shfl_xor(mq, o)); mk = fmaxf(mk, __shfl_xor(mk, o)); }
              if (lane == 0) { redm[wave] = mq; redm[8 + wave] = mk; } }
            __syncthreads();
            if (tid < 32) { float mq = redm[0], mk = redm[8];
#pragma unroll
                for (int i = 1; i < NWAVES; ++i) { mq = fmaxf(mq, redm[i]); mk = fmaxf(mk, redm[8 + i]); }
                const float T = 2.f * (ATT_SCALE * sqrtf(mq * mk) * 1.02f) + 27.f, c0 = cp0[tid];
                int j = 0; while (j < 4 * tid && c0 - cend[j] < -T) ++j;
                JLO[h * 32 + tid] = j & ~1; }
#pragma unroll
            for (int i = 0; i < 16; ++i) { const double cs = (base + loc[i]) * 11.313708498984761;
                const unsigned b1 = cvt_pk_bf16((float)cs, 0.f) & 0xffffu; const double r1 = cs - (double)__uint_as_float(b1 << 16);
                const unsigned b2 = cvt_pk_bf16((float)r1, 0.f) & 0xffffu; const double r2 = r1 - (double)__uint_as_float(b2 << 16);
                const unsigned b3 = cvt_pk_bf16((float)r2, 0.f) & 0xffffu; const unsigned one = 0x3f80u;
                const size_t e = ((size_t)h * S + tid * 16 + i) * 8;
                *(u32x4*)(QX + e) = (u32x4){b1 | (b2 << 16), b3 | (one << 16), one | (one << 16), 0u};
                *(u32x4*)(KX + e) = (u32x4){one | (one << 16), one | ((b1 ^ 0x8000u) << 16), (b2 ^ 0x8000u) | ((b3 ^ 0x8000u) << 16), 0u}; }
            __syncthreads();
        }
        const int r32 = lane & 31, hi5 = lane >> 5;
        constexpr int NITEM = 1152;
#define IDX_DECODE(it_, q0_, seg_, nadm_) do { int g_ = 0; while (32 * (g_ + 1) * (g_ + 2) / 2 <= (it_)) ++g_; \
            const int rem_ = (it_) - 32 * g_ * (g_ + 1) / 2, nseg_ = g_ + 1; q0_ = (g_ * 32 + rem_ / nseg_) * 32; seg_ = rem_ % nseg_; nadm_ = (q0_ / 64 + 1) * 64; } while (0)
#define IDX_STAGE_Q(b_, q0_) do { const bf16_t* qsrc_ = QI + (size_t)(q0_) * 1024; _Pragma("unroll") for (int i_ = 0; i_ < 8; ++i_) \
            pg8::glds16_s((const void*)qsrc_, (unsigned)((lane & 31) * 2048 + (2 * wave + 16 * i_ + (lane >> 5)) * 16), ldsb3 + (unsigned)(b_) * 65536u + (unsigned)(2 * wave + 16 * i_) * 512u); } while (0)
        const unsigned ldsb3 = (unsigned)(uintptr_t)F.lds;
        LAS float* const Wsb = (LAS float*)(F.lds + RING_BYTES + 1024);
        int it = blockIdx.x, buf = 0, q0 = 0, seg = 0, nadm = 0;
        __syncthreads();
        if (it < NITEM) { IDX_DECODE(it, q0, seg, nadm); IDX_STAGE_Q(0, q0); Wsb[(tid >> 5) * 32 + (tid & 31)] = WI[(size_t)(q0 + (tid & 31)) * 16 + (tid >> 5)]; }
        for (; it < NITEM; it += F.G) {
            const int kb0 = seg * 1024 + wave * 128; const bool act = kb0 < nadm;
            bf16x8 kf[4][4], qlf[4];
            if (act) {
#pragma unroll
                for (int j = 0; j < 4; ++j)
#pragma unroll
                    for (int ks = 0; ks < 4; ++ks) kf[j][ks] = *(const bf16x8*)(KI + (size_t)(kb0 + 32 * j + r32) * IDD + ks * 16 + hi5 * 8);
#pragma unroll
                for (int ks = 0; ks < 4; ++ks) qlf[ks] = *(const bf16x8*)(QLIN + (size_t)(q0 + r32) * IDD + ks * 16 + hi5 * 8);
            }
            VM_WAIT();
            __syncthreads();
            const int nit = it + F.G; const bool has_next = nit < NITEM; int nq0 = 0, nseg2 = 0, nnadm = 0; float wn = 0.f;
            if (has_next) { IDX_DECODE(nit, nq0, nseg2, nnadm); IDX_STAGE_Q(buf ^ 1, nq0); wn = WI[(size_t)(nq0 + (tid & 31)) * 16 + (tid >> 5)]; }
            if (act) {
                LAS unsigned char* Qs = F.lds + buf * 65536; LAS float* Ws = Wsb + buf * 512;
                f32x16 sacc[4];
#pragma unroll
                for (int j = 0; j < 4; ++j) sacc[j] = f32x16{};
#pragma unroll 2
                for (int h = 0; h < NIH; ++h) {
                    bf16x8 qf[4];
#pragma unroll
                    for (int ks = 0; ks < 4; ++ks) qf[ks] = *(const LAS bf16x8*)(Qs + (((h * 4 + ks) * 2 + hi5) * 32 + r32) * 16);
                    const float wh = Ws[h * 32 + r32];
#pragma unroll
                    for (int j = 0; j < 4; ++j) { f32x16 c = f32x16{};
#pragma unroll
                        for (int ks = 0; ks < 4; ++ks) c = __builtin_amdgcn_mfma_f32_32x32x16_bf16(kf[j][ks], qf[ks], c, 0, 0, 0);
                        float s0 = fmaf(wh, __builtin_fabsf(c[0]), sacc[j][0]); sacc[j][0] = s0;
#pragma unroll
                        for (int r = 1; r < 16; ++r) { float a_ = sacc[j][r]; asm("v_fma_f32 %0, %1, |%2|, %0" : "+v"(a_) : "v"(wh), "v"(c[r]), "v"(s0)); sacc[j][r] = a_; } }
                }
#pragma unroll
                for (int j = 0; j < 4; ++j) { f32x16 c = f32x16{};
#pragma unroll
                    for (int ks = 0; ks < 4; ++ks) c = __builtin_amdgcn_mfma_f32_32x32x16_bf16(kf[j][ks], qlf[ks], c, 0, 0, 0);
#pragma unroll
                    for (int r = 0; r < 16; ++r) sacc[j][r] = 0.5f * (sacc[j][r] + c[r]); }
                float* srow = SCORES + (size_t)(q0 + r32) * S;
#pragma unroll
                for (int j = 0; j < 4; ++j) if (kb0 + 32 * j < nadm) {
#pragma unroll
                    for (int rg = 0; rg < 4; ++rg) *(f32x4*)(srow + kb0 + 32 * j + 8 * rg + 4 * hi5) = (f32x4){sacc[j][4 * rg], sacc[j][4 * rg + 1], sacc[j][4 * rg + 2], sacc[j][4 * rg + 3]}; }
            }
            if (has_next) { Wsb[(buf ^ 1) * 512 + (tid >> 5) * 32 + (tid & 31)] = wn; q0 = nq0; seg = nseg2; nadm = nnadm; buf ^= 1; }
        }
        VM_WAIT(); __syncthreads();
#undef IDX_DECODE
#undef IDX_STAGE_Q
    }
    SEAM(3);

    PHASE(4) {
        constexpr int P4_CAP = 24, P4_WAVE_BYTES = 8448 + (P4_CAP + 1) * 256;
        LAS unsigned* hist = (LAS unsigned*)(F.lds + wave * P4_WAVE_BYTES);
        LAS unsigned* clist = hist + 2112;
        auto scan_hist = [&](unsigned kk, unsigned& bin_o, unsigned& cab_o, unsigned& cbin_o) __attribute__((always_inline)) {
            unsigned c32 = 0u;
#pragma unroll
            for (int j = 0; j < 32; ++j) c32 += hist[33 * lane + j];
            unsigned incl = c32;
#pragma unroll
            for (int o = 1; o < 64; o <<= 1) { const unsigned v = __shfl_down(incl, o); if (lane + o < 64) incl += v; }
            const unsigned above = incl - c32;
            const unsigned long long bal = __ballot((above < kk) && (kk <= incl));
            const int srcl = bal ? (int)__ffsll((long long)bal) - 1 : 0;
            const unsigned a0 = __shfl(above, srcl);
            const unsigned hj = (lane < 32) ? hist[33 * srcl + lane] : 0u;
            unsigned si = hj;
#pragma unroll
            for (int o = 1; o < 32; o <<= 1) { const unsigned v = __shfl_down(si, o); if (lane + o < 64) si += v; }
            const unsigned ab2 = a0 + si - hj;
            const unsigned long long bal2 = __ballot((lane < 32) && (ab2 < kk) && (kk <= ab2 + hj));
            const int j2 = bal2 ? (int)__ffsll((long long)bal2) - 1 : 0;
            bin_o = 32u * (unsigned)srcl + (unsigned)j2; cab_o = __shfl(ab2, j2); cbin_o = __shfl(hj, j2);
        };
        auto zero_hist = [&]() __attribute__((always_inline)) {
#pragma unroll
            for (int q = 0; q < 9; ++q) if (lane + 64 * q < 528) ((LAS u32x4*)hist)[lane + 64 * q] = (u32x4){0u, 0u, 0u, 0u};
            LDS_WAIT();
        };
        for (int t = gw; t < S; t += NGW) {
            const int n = (t / 64 + 1) * 64, nw = n / 64;
            unsigned long long w0 = 0ull, w1 = 0ull;
            if (n <= TOPK) { w0 = (lane < nw) ? ~0ull : 0ull; }
            else {
                const float* srow = SCORES + (size_t)t * S + lane;
                unsigned key[128];
#pragma unroll
                for (int i = 0; i < 128; ++i) key[i] = __float_as_uint(srow[64 * ((i < nw) ? i : 0)]);
#pragma unroll
                for (int i = 0; i < 128; ++i) { const unsigned u = key[i]; key[i] = (i < nw) ? ((u & 0x80000000u) ? ~u : (u | 0x80000000u)) : 0u; }
                unsigned prefix, kk = TOPK, bin, cab, cbin;
                zero_hist();
#pragma unroll
                for (int c = 0; c < 8; ++c) {
                    if (16 * c < nw) {
#pragma unroll
                        for (int j = 0; j < 16; ++j) { const unsigned d = key[16 * c + j] >> 21;
                            __hip_atomic_fetch_add(hist + (d + (d >> 5)), 1u, __ATOMIC_RELAXED, __HIP_MEMORY_SCOPE_WORKGROUP); }
                    }
                }
                LDS_WAIT();
                scan_hist(kk, bin, cab, cbin);
                kk -= cab; prefix = bin << 21;
                LDS_WAIT();
                unsigned cnt = 0u;
#pragma unroll
                for (int c = 0; c < 8; ++c) {
                    if (16 * c < nw) {
#pragma unroll
                        for (int j = 0; j < 16; ++j) { const unsigned k_ = key[16 * c + j];
                            clist[(cnt < (unsigned)P4_CAP ? cnt : (unsigned)P4_CAP) * 64u + lane] = k_;
                            cnt += ((k_ >> 21) == bin) ? 1u : 0u; }
                    }
                }
                unsigned mx = cnt;
#pragma unroll
                for (int o = 32; o > 0; o >>= 1) { const unsigned v = __shfl_xor(mx, o); mx = (v > mx) ? v : mx; }
                const int maxc = __builtin_amdgcn_readfirstlane((int)mx);
                LDS_WAIT();
#pragma unroll 1
                for (int pass = 1; pass < 3; ++pass) {
                    const int shift = (pass == 1) ? 10 : 0;
                    const unsigned dmask = (pass == 2) ? 1023u : 2047u;
                    const unsigned pmask = (pass == 1) ? 0xffe00000u : 0xfffffc00u;
                    zero_hist();
                    if (maxc <= P4_CAP) {
#pragma unroll 1
                        for (int s = 0; s < maxc; ++s) {
                            if ((unsigned)s < cnt) { const unsigned k_ = clist[s * 64 + lane];
                                if (((k_ ^ prefix) & pmask) == 0u) { const unsigned d = (k_ >> shift) & dmask;
                                    __hip_atomic_fetch_add(hist + (d + (d >> 5)), 1u, __ATOMIC_RELAXED, __HIP_MEMORY_SCOPE_WORKGROUP); } }
                        }
                    } else {
#pragma unroll
                        for (int c = 0; c < 8; ++c) {
                            if (16 * c < nw) {
#pragma unroll
                                for (int j = 0; j < 16; ++j) { const unsigned k_ = key[16 * c + j];
                                    if (((k_ ^ prefix) & pmask) == 0u) { const unsigned d = (k_ >> shift) & dmask;
                                        __hip_atomic_fetch_add(hist + (d + (d >> 5)), 1u, __ATOMIC_RELAXED, __HIP_MEMORY_SCOPE_WORKGROUP); } }
                            }
                        }
                    }
                    LDS_WAIT();
                    scan_hist(kk, bin, cab, cbin);
                    kk -= cab; prefix |= bin << shift;
                    LDS_WAIT();
                    if (kk == cbin) break;
                }
                int w0l = 0, w0h = 0, w1l = 0, w1h = 0;
#pragma unroll
                for (int i = 0; i < 64; ++i) { const unsigned long long b0 = __ballot(key[i] >= prefix), b1 = __ballot(key[64 + i] >= prefix);
                    w0l = wl_i32((int)(unsigned)b0, i, w0l); w0h = wl_i32((int)(unsigned)(b0 >> 32), i, w0h);
                    w1l = wl_i32((int)(unsigned)b1, i, w1l); w1h = wl_i32((int)(unsigned)(b1 >> 32), i, w1h); }
                w0 = ((unsigned long long)(unsigned)w0h << 32) | (unsigned)w0l; w1 = ((unsigned long long)(unsigned)w1h << 32) | (unsigned)w1l;
            }
            MASK[(size_t)t * 128 + lane] = w0; MASK[(size_t)t * 128 + 64 + lane] = w1;
        }
    }
    SEAM(4);

    PHASE(5) {
        LAS unsigned* qsl = (LAS unsigned*)(F.lds + fa::OFF_W + NWAVES * 64 * 4);
        unsigned* const qctr = (unsigned*)(ws + WS_CTL) + 2048;
        const int myx = (int)(xb_xcc_id() & 7u);
        if (MK_ATT_MODES & 1) for (int qi = 0; qi < NH; ++qi) { const int h = (myx + qi) & 7; const size_t ho = (size_t)h * S * HD;
            for (;;) {
                __syncthreads();
                { int l0; asm volatile("v_mbcnt_lo_u32_b32 %0, -1, 0\n\tv_mbcnt_hi_u32_b32 %0, -1, %0" : "=v"(l0)); if (wave == 0 && l0 == 0) qsl[0] = __hip_atomic_fetch_add(qctr + 64 * h, 1u, __ATOMIC_RELAXED, __HIP_MEMORY_SCOPE_AGENT); }
                __syncthreads();
                const unsigned idx = qsl[0]; if (idx >= 48u) break;
                const int ent = DSA_TAB[idx], qb = ent & 255, prt = ent >> 8, NTq = 4 * (qb + 1);
                const int jb = (prt == 2) ? NTq / 2 : 0, je = (prt == 1) ? NTq / 2 : NTq;
                const int slot = (h * 16 + (qb - 16)) * 2 + (prt - 1);
                fa::attn_block<0>((char*)lds_raw, PROJ + C_QA + h * HD, args.in[4], ROT, KA + ho, VA + ho, nullptr, nullptr, MASK, nullptr, OB, h * HD, 0, qb * 256, jb, je,
                                  prt ? PART + (size_t)slot * 256 * HD : nullptr, prt ? PML + (size_t)slot * 512 : nullptr);
            } }
        if (MK_ATT_MODES & 2) for (int qi = 0; qi < NH; ++qi) { const int h = (myx + qi) & 7; const size_t ho = (size_t)h * S * HD;
            for (;;) {
                __syncthreads();
                { int l0; asm volatile("v_mbcnt_lo_u32_b32 %0, -1, 0\n\tv_mbcnt_hi_u32_b32 %0, -1, %0" : "=v"(l0)); if (wave == 0 && l0 == 0) qsl[0] = __hip_atomic_fetch_add(qctr + 512 + 64 * h, 1u, __ATOMIC_RELAXED, __HIP_MEMORY_SCOPE_AGENT); }
                __syncthreads();
                const unsigned idx = qsl[0]; if (idx >= 32u) break;
                const int qb = 31 - (int)idx;
                const int jb = __builtin_amdgcn_readfirstlane(JLO[h * 32 + qb]);
                fa::attn_block<1>((char*)lds_raw, PROJ + C_QB + h * HD, args.in[6], nullptr, KB + ho, VB + ho, QX + (size_t)h * S * 8, KX + (size_t)h * S * 8, nullptr, GBG, OB, 1024 + h * HD, h * HD, qb * 256, jb, 4 * (qb + 1), nullptr, nullptr);
            } }
        __syncthreads();
    }
    { int l2; asm volatile("v_mbcnt_lo_u32_b32 %0, -1, 0\n\tv_mbcnt_hi_u32_b32 %0, -1, %0" : "=v"(l2)); lane = l2; tid = wave * 64 + l2; }
    SEAM(5);

    PHASE(6) {
        for (int u = F.vcu; u < 256; u += F.G) {
            const int blk = u >> 1, h = blk >> 4, qb = 16 + (blk & 15), row = (u & 1) * 128 + (tid >> 2), cq = (tid & 3) * 32;
            const float* p1 = PART + (size_t)(blk * 2) * 256 * HD + (size_t)row * HD + cq; const float* p2 = p1 + (size_t)256 * HD;
            const float* ml1 = PML + (size_t)(blk * 2) * 512 + row * 2; const float* ml2 = ml1 + 512;
            const float m1 = ml1[0], l1 = ml1[1], m2 = ml2[0], l2 = ml2[1], m = fmaxf(m1, m2);
            constexpr float C2 = 1.4426950408889634f * ATT_SCALE;
            const float a1 = __builtin_amdgcn_exp2f((m1 - m) * C2), a2 = __builtin_amdgcn_exp2f((m2 - m) * C2), rl = 1.f / (l1 * a1 + l2 * a2), w1 = a1 * rl, w2 = a2 * rl;
            bf16_t* op = OB + (size_t)(qb * 256 + row) * DM + h * HD + cq;
#pragma unroll
            for (int c = 0; c < 4; ++c) { const f32x4 x0 = *(const f32x4*)(p1 + 8 * c) * w1 + *(const f32x4*)(p2 + 8 * c) * w2, x1 = *(const f32x4*)(p1 + 8 * c + 4) * w1 + *(const f32x4*)(p2 + 8 * c + 4) * w2;
                u32x4 w; w.x = cvt_pk_bf16(x0[0], x0[1]); w.y = cvt_pk_bf16(x0[2], x0[3]); w.z = cvt_pk_bf16(x1[0], x1[1]); w.w = cvt_pk_bf16(x1[2], x1[3]);
                *(u32x4*)(op + 8 * c) = w; }
        }
    }
    SEAM(6);

    PHASE(7) {
        pg8::SchedPlain Sd{(const char*)OB, (const char*)WOUT, S / 256, DM / 256, F.G, gcid, (size_t)256 * DM * 2};
        pg8::EpiResid E{x_in, X1, DM, nullptr, 1.f};
        pg8::gemm_phase(F.lds, DM * 2, DM * 2 / 128, Sd, E);
    }
    SEAM(7);

    PHASE(8) { for (int m = gw; m < S; m += NGW) rms_row_to_bf16(X1 + (size_t)m * DM, args.in[9], HB + (size_t)m * DM, lane); }
    SEAM(8);

    PHASE(9) {
        pg8::SchedPlain Sd{(const char*)HB, (const char*)WGU, S / 256, 2 * DFF / 256, F.G, gcid, (size_t)256 * DM * 2};
        pg8::EpiSwiglu E{ACT, DFF};
        pg8::gemm_phase(F.lds, DM * 2, DM * 2 / 128, Sd, E);
    }
    SEAM(9);

    PHASE(10) {
        pg8::SchedPlain Sd{(const char*)ACT, (const char*)WDN, S / 256, DM / 256, F.G, gcid, (size_t)256 * DFF * 2};
        pg8::EpiResid E{X1, X2, DM, nullptr, 1.f};
        pg8::gemm_phase(F.lds, DFF * 2, DFF * 2 / 128, Sd, E);
    }
    SEAM(10);

    PHASE(11) {
        LAS float* part = (LAS float*)F.lds;
        LAS float* rs = part + 47 * NWAVES;
        const int RB = S / F.G, r0 = F.vcu * RB;
        const int c4 = tid * 4, grp = wave >> 1;
        const f32x4 g4 = *(const f32x4*)(args.in[13] + c4);
        const float* xc = X2 + c4;
        for (int rb = r0; rb < r0 + RB; rb += 32) {
            f32x4 v[32], h[15];
#pragma unroll
            for (int i = 0; i < 32; ++i) v[i] = *(const f32x4*)(xc + (size_t)(rb + i) * DM);
#pragma unroll
            for (int j = 0; j < 15; ++j) { const int row = rb - 1 - j; h[j] = *(const f32x4*)(xc + (size_t)((row >= 0) ? row : rb) * DM) * ((row >= 0) ? 1.f : 0.f); }
#pragma unroll
            for (int k = 0; k < 47; ++k) { const f32x4 x = (k < 15) ? h[(k < 15) ? 14 - k : 0] : v[(k >= 15) ? k - 15 : 0];
                const float s = wave_sum((x.x * x.x + x.y * x.y) + (x.z * x.z + x.w * x.w)); if (lane == 0) part[k * NWAVES + wave] = s; }
            __syncthreads();
            if (tid < 47) { float s = 0.f;
#pragma unroll
                for (int w = 0; w < NWAVES; ++w) s += part[tid * NWAVES + w];
                rs[tid] = 1.f / sqrtf(s * (1.f / DM) + RMS_EPS); }
            __syncthreads();
            bf16_t* po = POOLED + ((size_t)grp * S + rb) * 512 + (c4 & 511);
#define POOL_BODY(W) do { f32x4 s4 = (f32x4){0.f, 0.f, 0.f, 0.f}; \
            _Pragma("unroll") for (int j = 1; j < (W); ++j) s4 += h[j - 1] * rs[15 - j]; \
            _Pragma("unroll") for (int i = 0; i < 32; ++i) { const int t = rb + i; const f32x4 vi = v[i] * rs[15 + i]; \
                s4 += vi; \
                const float rc = 1.f / (float)((t + 1 < (W)) ? (t + 1) : (W)); \
                const f32x4 p = (s4 * rc - vi) * g4; \
                s4 -= ((i - (W) + 1 >= 0) ? v[(i - (W) + 1 >= 0) ? i - (W) + 1 : 0] : h[((W) - 2 - i >= 0) ? (W) - 2 - i : 0]) * rs[15 + i - (W) + 1];        \
                u32x2 w; w.x = cvt_pk_bf16(p.x, p.y); w.y = cvt_pk_bf16(p.z, p.w); \
                *(u32x2*)(po + (size_t)i * 512) = w; } } while (0)
            if (grp == 0) POOL_BODY(2); else if (grp == 1) POOL_BODY(4); else if (grp == 2) POOL_BODY(8); else POOL_BODY(16);
#undef POOL_BODY
            __syncthreads();
        }
    }
    SEAM(11);

    PHASE(12) {
        pg8::SchedPool Sd{(const char*)POOLED, (const char*)WPOOL, S / 256, DM / 256, F.G, gcid, (size_t)256 * 512 * 2, (size_t)S * 512 * 2};
        pg8::EpiResid E{X2, X3, DM, args.in[15], 1.f};
        pg8::gemm_phase(F.lds, 512 * 2, 8, Sd, E);
    }
    SEAM(12);

    PHASE(13) {
        const int RB = S / F.G, r0 = F.vcu * RB;
        LAS unsigned* es = (LAS unsigned*)F.lds;
        const float* gain = args.in[16]; const float* router = args.in[17];
        for (int ib = 4 * wave; ib < RB; ib += 4 * NWAVES) {
            float ss[4], lg[4][8];
#pragma unroll
            for (int q = 0; q < 4; ++q) { ss[q] = 0.f;
#pragma unroll
                for (int e = 0; e < 8; ++e) lg[q][e] = 0.f; }
            f32x4 xn[4];
#pragma unroll
            for (int q = 0; q < 4; ++q) xn[q] = *(const f32x4*)(X3 + (size_t)(r0 + ib + q) * DM + 4 * lane);
#pragma unroll 1
            for (int j = 0; j < 8; ++j) { const int k0 = 4 * (lane + 64 * j); const f32x4 g = *(const f32x4*)(gain + k0);
                f32x4 rr[4][2];
#pragma unroll
                for (int c = 0; c < 4; ++c) { rr[c][0] = *(const f32x4*)(router + (size_t)(k0 + c) * 8); rr[c][1] = *(const f32x4*)(router + (size_t)(k0 + c) * 8 + 4); }
                f32x4 xq[4];
#pragma unroll
                for (int q = 0; q < 4; ++q) xq[q] = xn[q];
                if (j < 7) {
#pragma unroll
                    for (int q = 0; q < 4; ++q) xn[q] = *(const f32x4*)(X3 + (size_t)(r0 + ib + q) * DM + k0 + 256); }
#pragma unroll
                for (int q = 0; q < 4; ++q) { const f32x4 x = xq[q]; ss[q] += (x.x * x.x + x.y * x.y) + (x.z * x.z + x.w * x.w); xq[q] = x * g; }
#pragma unroll
                for (int c = 0; c < 4; ++c) { const f32x4 ra = rr[c][0], rb = rr[c][1];
#pragma unroll
                    for (int q = 0; q < 4; ++q) { const float hv = xq[q][c];
                        lg[q][0] += hv * ra.x; lg[q][1] += hv * ra.y; lg[q][2] += hv * ra.z; lg[q][3] += hv * ra.w; lg[q][4] += hv * rb.x; lg[q][5] += hv * rb.y; lg[q][6] += hv * rb.z; lg[q][7] += hv * rb.w; } } }
            float rstd[4];
#pragma unroll
            for (int q = 0; q < 4; ++q) rstd[q] = 1.f / sqrtf(wave_sum(ss[q]) * (1.f / DM) + RMS_EPS);
#pragma unroll
            for (int q = 0; q < 4; ++q) { const int t = r0 + ib + q;
#pragma unroll
                for (int e = 0; e < 8; ++e) lg[q][e] = wave_sum(lg[q][e]) * rstd[q];
                int e1 = 0; float v1 = lg[q][0];
#pragma unroll
                for (int e = 1; e < 8; ++e) if (lg[q][e] > v1) { v1 = lg[q][e]; e1 = e; }
                int e2 = -1; float v2 = -__builtin_inff();
#pragma unroll
                for (int e = 0; e < 8; ++e) if (e != e1 && lg[q][e] > v2) { v2 = lg[q][e]; e2 = e; }
                const float g1 = 1.f / (1.f + __expf(v2 - v1)), g2 = 1.f - g1;
                if (lane == 0) { TOKE[t] = (unsigned)e1 | ((unsigned)e2 << 8); TOKG[t] = (f32x2){g1, g2}; RSTD3[t] = rstd[q]; es[ib + q] = (unsigned)e1 | ((unsigned)e2 << 8); } }
        }
        __syncthreads();
        if (tid < 8) { unsigned c = 0; for (int i = 0; i < RB; ++i) { const unsigned w = es[i]; c += ((w & 255u) == (unsigned)tid) + (((w >> 8) & 255u) == (unsigned)tid); } CNT[F.vcu * 8 + tid] = c; }
        __syncthreads();
    }
    SEAM(13);

    PHASE(14) {
        const int RB = S / F.G, r0 = F.vcu * RB;
        LAS unsigned* cnts = (LAS unsigned*)F.lds;
        LAS unsigned* tot = cnts + 2048; LAS unsigned* offs = tot + 8; LAS unsigned* base = offs + 8; LAS unsigned* es = base + 8; LAS unsigned* sl = es + 64;
        for (int i = tid; i < F.G * 8; i += NTHREADS) cnts[i] = CNT[i];
        if (tid < RB) es[tid] = TOKE[r0 + tid];
        __syncthreads();
        { unsigned t_ = 0, o_ = 0;
          for (int w = lane; w < F.G; w += 64) { const unsigned c = cnts[w * 8 + wave]; t_ += c; if (w < F.vcu) o_ += c; }
#pragma unroll
          for (int o = 1; o < 64; o <<= 1) { t_ += __shfl_xor(t_, o); o_ += __shfl_xor(o_, o); }
          if (lane == 0) { tot[wave] = t_; offs[wave] = o_; } }
        __syncthreads();
        if (tid == 0) { unsigned b = 0; for (int e = 0; e < 8; ++e) { base[e] = b; b += (tot[e] + 255u) & ~255u; }
            if (blockIdx.x == 0) { int pm = 0; for (int e = 0; e < 8; ++e) { const int nt_ = (int)((tot[e] + 255u) >> 8); for (int i = 0; i < nt_; ++i) TEXP[pm++] = e; } TEXP[127] = pm; { int cu = 0; for (int e = 0; e < 7; ++e) { cu += (int)((tot[e] + 255u) >> 8); TEXP[112 + e] = cu; } } } }
        __syncthreads();
        if (tid < RB) { const unsigned w = es[tid]; const unsigned e1 = w & 255u, e2 = (w >> 8) & 255u; unsigned k1 = 0, k2 = 0;
            for (int i = 0; i < tid; ++i) { const unsigned o = es[i]; const unsigned a = o & 255u, b = (o >> 8) & 255u; k1 += (a == e1) + (b == e1); k2 += (a == e2) + (b == e2); }
            const unsigned s1 = base[e1] + offs[e1] + k1, s2 = base[e2] + offs[e2] + k2;
            sl[2 * tid] = s1; sl[2 * tid + 1] = s2; SLOT[r0 + tid] = (u32x2){s1, s2}; }
        __syncthreads();
        const float* gain = args.in[16];
        for (int i = wave; i < RB; i += NWAVES) { const int t = r0 + i; const float rstd = RSTD3[t] * F8_HSCALE;
            const f32x4* xr = (const f32x4*)(X3 + (size_t)t * DM) + lane; const f32x4* gr = (const f32x4*)gain + lane;
            unsigned* o1 = (unsigned*)(HS8 + (size_t)sl[2 * i] * DM) + lane; unsigned* o2 = (unsigned*)(HS8 + (size_t)sl[2 * i + 1] * DM) + lane;
#pragma unroll
            for (int j = 0; j < 8; ++j) { const f32x4 v = xr[64 * j], g = gr[64 * j]; const unsigned w = pk4_fp8(v.x * rstd * g.x, v.y * rstd * g.y, v.z * rstd * g.z, v.w * rstd * g.w); o1[64 * j] = w; o2[64 * j] = w; } }
        if (blockIdx.x < 8) { const int e = blockIdx.x; const unsigned p0 = base[e] + tot[e], p1 = base[e] + ((tot[e] + 255u) & ~255u);
            for (unsigned r = p0 + wave; r < p1; r += NWAVES) { u32x2* o = (u32x2*)(HS8 + (size_t)r * DM) + lane;
#pragma unroll
                for (int j = 0; j < 4; ++j) o[64 * j] = (u32x2){0u, 0u}; } }
        __syncthreads();
        { unsigned* const cq = (unsigned*)(ws + WS_CTL) + 3072;
          for (;;) {
            if (tid == 0) MISC[15] = __hip_atomic_fetch_add(cq, 4u, __ATOMIC_RELAXED, __HIP_MEMORY_SCOPE_AGENT);
            __syncthreads();
            const unsigned b0 = MISC[15];
            if (b0 >= (unsigned)MOE_NB) break;
#pragma unroll 1
            for (int q = 0; q < 4; ++q) if (b0 + q < (unsigned)MOE_NB) moe_cvt_batch(args.in[18], args.in[19], args.in[20], ws, (int)(b0 + q), wave, lane);
            __syncthreads();
            if (b0 + 4u >= (unsigned)MOE_NB_GU) break;
          } }
    }
    SEAM(14);

    PHASE(15) {
        const int ntile = __builtin_amdgcn_readfirstlane(TEXP[127]);
        pg8::ExpCum cum; { const int cv = (lane < 7) ? TEXP[112 + lane] : 0;
#pragma unroll
            for (int j = 0; j < 7; ++j) cum.c[j] = __builtin_amdgcn_readlane(cv, j); }
        pg8::SchedMoe Sd{(const char*)HS8, (const char*)MWGU8, cum, ntile, 2 * DFFE / 256, F.G, gcid, (size_t)256 * DM, (size_t)14336 * DM, 0};
        pg8::EpiSwigluF8 E{ACTM8, DFFE, 1.f / (F8_HSCALE * F8_WSCALE), F8_ASCALE};
        pg8::gemm_phase<pg8::EpiSwigluF8, pg8::SchedMoe, true>(F.lds, DM, DM / 128, Sd, E);
        { unsigned* const cq = (unsigned*)(ws + WS_CTL) + 3072;
          for (;;) {
            __syncthreads();
            if (tid == 0) MISC[15] = __hip_atomic_fetch_add(cq, 4u, __ATOMIC_RELAXED, __HIP_MEMORY_SCOPE_AGENT);
            __syncthreads();
            const unsigned b0 = MISC[15];
            if (b0 >= (unsigned)MOE_NB) break;
#pragma unroll 1
            for (int q = 0; q < 4; ++q) if (b0 + q < (unsigned)MOE_NB) moe_cvt_batch(args.in[18], args.in[19], args.in[20], ws, (int)(b0 + q), wave, lane);
          } }
    }
    SEAM(15);

    PHASE(16) {
        const int ntile = __builtin_amdgcn_readfirstlane(TEXP[127]);
        pg8::ExpCum cum; { const int cv = (lane < 7) ? TEXP[112 + lane] : 0;
#pragma unroll
            for (int j = 0; j < 7; ++j) cum.c[j] = __builtin_amdgcn_readlane(cv, j); }
        const int nsplit = ntile & 31;
        { pg8::SchedMoe Sd{(const char*)ACTM8, (const char*)MWDN8, cum, ntile - nsplit, DM / 256, F.G, gcid, (size_t)256 * DFFE, (size_t)DM * DFFE, 0};
          pg8::EpiStoreBf16 E{YM, DM, 1.f / (F8_ASCALE * F8_WSCALE)};
          pg8::gemm_phase<pg8::EpiStoreBf16, pg8::SchedMoe, true>(F.lds, DFFE, DFFE / 128, Sd, E); }
        if (nsplit > 0 && nsplit <= 8) {
          pg8::SchedMoeSplit Sd{(const char*)ACTM8, (const char*)MWDN8, cum, ntile - nsplit, 32 * nsplit, F.G, gcid, (size_t)256 * DFFE, (size_t)DM * DFFE, (size_t)(DFFE / 4)};
          pg8::EpiResid E{nullptr, YMP, DM, nullptr, 1.f / (F8_ASCALE * F8_WSCALE)};
          pg8::gemm_phase<pg8::EpiResid, pg8::SchedMoeSplit, true>(F.lds, DFFE, DFFE / 4 / 128, Sd, E); }
        else if (nsplit > 8) {
          pg8::SchedMoe Sd{(const char*)ACTM8 + (size_t)(ntile - nsplit) * 256 * DFFE, (const char*)MWDN8, cum, nsplit, DM / 256, F.G, gcid, (size_t)256 * DFFE, (size_t)DM * DFFE, ntile - nsplit};
          pg8::EpiStoreBf16 E{YM + (size_t)(ntile - nsplit) * 256 * DM, DM, 1.f / (F8_ASCALE * F8_WSCALE)};
          pg8::gemm_phase<pg8::EpiStoreBf16, pg8::SchedMoe, true>(F.lds, DFFE, DFFE / 128, Sd, E); }
    }
    SEAM(16);

    PHASE(17) {
        const int ntile = __builtin_amdgcn_readfirstlane(TEXP[127]); const int nsp = ntile & 31, sbase = (nsp > 0 && nsp <= 8) ? (ntile - nsp) * 256 : (1 << 30);
        for (int t = gw; t < S; t += NGW) { const u32x2 sl = SLOT[t]; const f32x2 g = TOKG[t];
            const f32x4* xr = (const f32x4*)(X3 + (size_t)t * DM) + lane; f32x4* o = (f32x4*)(args.out + (size_t)t * DM) + lane;
            f32x4 y[2][8];
#pragma unroll
            for (int q = 0; q < 2; ++q) { const int s_ = (int)(q ? sl.y : sl.x);
                if (s_ < sbase) { const u32x2* yp = (const u32x2*)(YM + (size_t)s_ * DM) + lane;
#pragma unroll
                    for (int j = 0; j < 8; ++j) { const u32x2 w = yp[64 * j]; y[q][j] = (f32x4){bf_lo(w.x), bf_hi(w.x), bf_lo(w.y), bf_hi(w.y)}; } }
                else { const f32x4* yp = (const f32x4*)(YMP + (size_t)(s_ - sbase) * DM) + lane;
#pragma unroll
                    for (int j = 0; j < 8; ++j) y[q][j] = (yp[64 * j] + yp[64 * j + (size_t)2048 * DM / 4]) + (yp[64 * j + (size_t)2 * 2048 * DM / 4] + yp[64 * j + (size_t)3 * 2048 * DM / 4]); } }
#pragma unroll
            for (int j = 0; j < 8; ++j) o[64 * j] = xr[64 * j] + (y[0][j] * g.x + y[1][j] * g.y); }
    }
#undef IN
#undef SEAM
}

extern "C" void kernel_launch(void* const* d_in, const int* in_sizes, int n_in, void* d_out, int out_size, void* d_ws, size_t ws_size, hipStream_t stream) {
    static int grid = 0;
    if (grid == 0) {
        if (n_in != 21 || in_sizes[0] != S * DM || out_size != S * DM || ws_size < WS_END) { fprintf(stderr, "kernel_launch: unexpected shapes (n_in %d, in0 %d, out %d, ws %zu)\n", n_in, n_in > 0 ? in_sizes[0] : -1, out_size, ws_size); grid = -1; return; }
        int dev = 0, cus = 0, per_cu = 0;
        if (hipGetDevice(&dev) != hipSuccess || hipDeviceGetAttribute(&cus, hipDeviceAttributeMultiprocessorCount, dev) != hipSuccess) { grid = -1; return; }
        if (hipFuncSetAttribute((const void*)mega_fwd, hipFuncAttributeMaxDynamicSharedMemorySize, LDS_BYTES) != hipSuccess) { fprintf(stderr, "kernel_launch: hipFuncSetAttribute failed\n"); grid = -1; return; }
        if (hipOccupancyMaxActiveBlocksPerMultiprocessor(&per_cu, (const void*)mega_fwd, NTHREADS, LDS_BYTES) != hipSuccess || per_cu < 1) fprintf(stderr, "kernel_launch: occupancy query reports %d\n", per_cu);
        (void)hipGetLastError();
        grid = cus;
        while (grid > 1 && (S % grid != 0 || grid > 256)) --grid;
    }
    if (grid < 0) return;
    (void)hipMemsetAsync((char*)d_ws + WS_CTL, 0, CTL_ZERO_BYTES, stream);
    Args a{};
    for (int i = 0; i < 21; ++i) a.in[i] = (const float*)d_in[i];
    a.out = (float*)d_out; a.ws = (unsigned char*)d_ws;
#if MK_FUSED
#if MK_PROBE_HI > 0
    a.ph_lo = 0; a.ph_hi = MK_PROBE_HI;
    hipLaunchKernelGGL(mega_fwd, dim3(grid), dim3(NTHREADS), LDS_BYTES, stream, a);
    (void)hipMemsetAsync((char*)d_ws + WS_CTL, 0, CTL_ZERO_BYTES, stream);
    a.ph_lo = MK_PROBE_LO; a.ph_hi = 18;
    hipLaunchKernelGGL(mega_fwd, dim3(grid), dim3(NTHREADS), LDS_BYTES, stream, a);
#else
    a.ph_lo = 0; a.ph_hi = 18;
    hipLaunchKernelGGL(mega_fwd, dim3(grid), dim3(NTHREADS), LDS_BYTES, stream, a);
#endif
#else
    for (int p = 0; p < 18; ++p) { a.ph_lo = p; a.ph_hi = p + 1; hipLaunchKernelGGL(mega_fwd, dim3(grid), dim3(NTHREADS), LDS_BYTES, stream, a); }
#endif
}
```
